# Optimizing an MI355X kernel written in HIP

```python
import math
import jax, jax.numpy as jnp
from jax import lax
import numpy as np

D_MODEL = 1024
BATCH = 8
SEQ = 2048
DEPTH = 1

CTX_LEN = 256
GRID_W = 64
CONV_WIDTH = D_MODEL // 2
CONV_GROUPS = 8
SSD_WIDTH = D_MODEL - CONV_WIDTH
SSD_HEADDIM = 64
SSD_HEADS = SSD_WIDTH // SSD_HEADDIM
SSD_GROUPS = 2
SSD_STATE = 128
SSD_CHUNK = 128
N_DIRS = 2
D_FF = 4 * D_MODEL
LN_EPS = 1e-5
RMS_EPS = 1e-5

SSD_GN = SSD_GROUPS * SSD_STATE
XBC_DIM = SSD_WIDTH + 2 * SSD_GN
SSD_TAIL = XBC_DIM + N_DIRS * SSD_HEADS
Z_OFF = 3 * CONV_WIDTH
XBC_OFF = Z_OFF + SSD_WIDTH
IN_DIM = XBC_OFF + SSD_TAIL

kernel_name = "hybrid_conv_ssd_dit_block"


def layer_norm(x, g, b):
    xf = x.astype(jnp.float32)
    mu = jnp.mean(xf, -1, keepdims=True)
    var = jnp.mean(jnp.square(xf - mu), -1, keepdims=True)
    return ((xf - mu) * lax.rsqrt(var + LN_EPS) * g + b).astype(x.dtype)


def dwconv3(x, w, axis):
    n = x.shape[axis]
    pad = [(0, 0)] * x.ndim
    pad[axis] = (1, 1)
    xp = jnp.pad(x, pad)
    sl = lambda s: lax.slice_in_dim(xp, s, s + n, axis=axis)
    return sl(0) * w[0] + sl(1) * w[1] + sl(2) * w[2]


def token_conv(x, w, is_grid):
    if is_grid:
        bsz, l, ch = x.shape
        rows = l // GRID_W
        return dwconv3(x.reshape(bsz, rows, GRID_W, ch), w, 2).reshape(bsz, l, ch)
    return dwconv3(x, w, 1)


def segsum(a):
    t = a.shape[-1]
    cs = jnp.cumsum(a, -1)
    diff = cs[..., :, None] - cs[..., None, :]
    mask = jnp.tril(jnp.ones((t, t), dtype=bool))
    return jnp.where(mask, diff, -jnp.inf)


def ssd_chunked(x, dt, a, bmat, cmat, h0):
    bsz, l, h, p = x.shape
    nc = l // SSD_CHUNK
    xdt = (x * dt[..., None]).reshape(bsz, nc, SSD_CHUNK, h, p)
    bc = bmat.reshape(bsz, nc, SSD_CHUNK, h, SSD_STATE)
    cc = cmat.reshape(bsz, nc, SSD_CHUNK, h, SSD_STATE)
    adt = jnp.moveaxis((dt * a).reshape(bsz, nc, SSD_CHUNK, h), -1, 1)
    acs = jnp.cumsum(adt, -1)
    lmat = jnp.exp(segsum(adt))
    scores = jnp.einsum('bclhn,bcshn->bhcls', cc, bc) * lmat
    y_diag = jnp.einsum('bhcls,bcshp->bclhp', scores, xdt)
    decay_states = jnp.exp(acs[..., -1:] - acs)
    local = jnp.einsum('bclhn,bhcl,bclhp->bchpn', bc, decay_states, xdt)
    states_in = jnp.concatenate([h0[:, None], local[:, :-1]], axis=1)
    a_last = jnp.pad(acs[..., -1][..., :-1], ((0, 0), (0, 0), (1, 0)))
    decay_chunk = jnp.exp(segsum(a_last))
    prev = jnp.einsum('bhzc,bchpn->bzhpn', decay_chunk, states_in)
    y_off = jnp.einsum('bclhn,bchpn,bhcl->bclhp', cc, prev, jnp.exp(acs))
    return (y_diag + y_off).reshape(bsz, l, h, p)


def ssd_final_state(x, dt, a, bmat):
    acs = jnp.cumsum(dt * a, axis=1)
    w = jnp.exp(acs[:, -1:] - acs) * dt
    return jnp.einsum('blh,blhn,blhp->bhpn', w, bmat, x)


def ssd_inputs(p, conv_w, conv_b, dt_bias, is_grid):
    bsz, l, _ = p.shape
    xbc = jax.nn.silu(token_conv(p[..., :XBC_DIM], conv_w, is_grid) + conv_b).astype(jnp.float32)
    xs = xbc[..., :SSD_WIDTH].reshape(bsz, l, SSD_HEADS, SSD_HEADDIM)
    bm = xbc[..., SSD_WIDTH:SSD_WIDTH + SSD_GN].reshape(bsz, l, SSD_GROUPS, SSD_STATE)
    cm = xbc[..., SSD_WIDTH + SSD_GN:].reshape(bsz, l, SSD_GROUPS, SSD_STATE)
    rep = SSD_HEADS // SSD_GROUPS
    bm = jnp.repeat(bm, rep, axis=2)
    cm = jnp.repeat(cm, rep, axis=2)
    dt_raw = p[..., XBC_DIM:].astype(jnp.float32).reshape(bsz, l, N_DIRS, SSD_HEADS)
    dt = jax.nn.softplus(dt_raw + dt_bias.astype(jnp.float32))
    return xs, bm, cm, dt


def mixer_out(proj, h0_f, h0_b, is_grid, conv_w, ssd_conv_w, ssd_conv_b, dt_bias, a,
              ssd_d, ssd_norm_w, w_out):
    gb = proj[..., :CONV_WIDTH]
    gc = proj[..., CONV_WIDTH:2 * CONV_WIDTH]
    gh = proj[..., 2 * CONV_WIDTH:3 * CONV_WIDTH]
    y_conv = gb * token_conv(gc * gh, conv_w, is_grid)
    z = proj[..., Z_OFF:XBC_OFF]
    xs, bm, cm, dt = ssd_inputs(proj[..., XBC_OFF:], ssd_conv_w, ssd_conv_b, dt_bias, is_grid)
    fl = lambda t: jnp.flip(t, 1)
    y_f = ssd_chunked(xs, dt[:, :, 0], a[0], bm, cm, h0_f)
    y_b = ssd_chunked(fl(xs), fl(dt[:, :, 1]), a[1], fl(bm), fl(cm), h0_b)
    y = y_f + fl(y_b) + xs * ssd_d.astype(jnp.float32)[:, None]
    bsz, l = y.shape[:2]
    yg = y.reshape(bsz, l, SSD_WIDTH) * jax.nn.silu(z.astype(jnp.float32))
    y_ssd = yg * lax.rsqrt(jnp.mean(jnp.square(yg), -1, keepdims=True) + RMS_EPS) * ssd_norm_w
    merged = jnp.concatenate([y_conv, y_ssd.astype(proj.dtype)], axis=-1)
    return merged @ w_out


def sq_relu_mlp(u, w1, w2):
    return jnp.square(jax.nn.relu(u @ w1)) @ w2


def setup_inputs(seed: int = 0) -> dict:
    key = jax.random.key(seed)
    ks = jax.random.split(key, 24)
    beta = (8.0 * DEPTH) ** -0.25
    nrm = lambda k, shape, s: jax.random.normal(k, shape, jnp.float32) * s
    x = nrm(ks[0], (BATCH, SEQ, D_MODEL), 1.0)
    c = nrm(ks[1], (BATCH, D_MODEL), 1.0)
    ctx = nrm(ks[2], (BATCH, CTX_LEN, D_MODEL), 1.0)
    c_ctx = nrm(ks[3], (D_MODEL,), 1.0)
    ln_in_g = 1.0 + nrm(ks[4], (D_MODEL,), 0.02)
    ln_in_b = nrm(ks[5], (D_MODEL,), 0.02)
    w_mod = nrm(ks[6], (DEPTH, D_MODEL, 6 * D_MODEL), D_MODEL ** -0.5)
    b_mod = nrm(ks[7], (DEPTH, 6 * D_MODEL), 0.02)
    w_in = nrm(ks[8], (DEPTH, D_MODEL, IN_DIM), D_MODEL ** -0.5)
    conv_w = nrm(ks[9], (DEPTH, 3, CONV_WIDTH), 3.0 ** -0.5)
    ssd_conv_w = nrm(ks[10], (DEPTH, 3, XBC_DIM), 3.0 ** -0.5)
    ssd_conv_b = nrm(ks[11], (DEPTH, XBC_DIM), 0.02)
    dt0 = jnp.exp(jax.random.uniform(ks[12], (DEPTH, N_DIRS, SSD_HEADS), jnp.float32,
                                     minval=math.log(1e-3), maxval=math.log(1e-1)))
    dt_bias = dt0 + jnp.log(-jnp.expm1(-dt0))
    a_log = jnp.log(jax.random.uniform(ks[13], (DEPTH, N_DIRS, SSD_HEADS), jnp.float32,
                                       minval=1.0, maxval=16.0))
    ssd_d = 1.0 + nrm(ks[14], (DEPTH, SSD_HEADS), 0.1)
    ssd_norm_w = 1.0 + nrm(ks[15], (DEPTH, SSD_WIDTH), 0.02)
    w_out = nrm(ks[16], (DEPTH, D_MODEL, D_MODEL), beta * D_MODEL ** -0.5)
    ln1_g = 1.0 + nrm(ks[17], (DEPTH, D_MODEL), 0.02)
    ln1_b = nrm(ks[18], (DEPTH, D_MODEL), 0.02)
    w_ff1 = nrm(ks[19], (DEPTH, D_MODEL, D_FF), D_MODEL ** -0.5)
    w_ff2 = nrm(ks[20], (DEPTH, D_FF, D_MODEL), beta * D_FF ** -0.5)
    ln2_g = 1.0 + nrm(ks[21], (DEPTH, D_MODEL), 0.02)
    ln2_b = nrm(ks[22], (DEPTH, D_MODEL), 0.02)
    return {"x": x, "c": c, "ctx": ctx, "c_ctx": c_ctx,
            "ln_in_g": ln_in_g, "ln_in_b": ln_in_b, "w_mod": w_mod, "b_mod": b_mod,
            "w_in": w_in, "conv_w": conv_w, "ssd_conv_w": ssd_conv_w, "ssd_conv_b": ssd_conv_b,
            "dt_bias": dt_bias, "a_log": a_log, "ssd_d": ssd_d, "ssd_norm_w": ssd_norm_w,
            "w_out": w_out, "ln1_g": ln1_g, "ln1_b": ln1_b, "w_ff1": w_ff1, "w_ff2": w_ff2,
            "ln2_g": ln2_g, "ln2_b": ln2_b}


def reference(x, c, ctx, c_ctx, ln_in_g, ln_in_b, w_mod, b_mod, w_in, conv_w, ssd_conv_w,
              ssd_conv_b, dt_bias, a_log, ssd_d, ssd_norm_w, w_out, ln1_g, ln1_b, w_ff1, w_ff2,
              ln2_g, ln2_b):
    alpha = (2.0 * DEPTH) ** 0.25
    h = layer_norm(x, ln_in_g, ln_in_b)
    hc = layer_norm(ctx, ln_in_g, ln_in_b)
    c_lat = jax.nn.silu(c)[:, None, :]
    c_con = jax.nn.silu(c_ctx)[None, None, :]
    for i in range(DEPTH):
        last = i == DEPTH - 1
        sh1, sc1, g1, sh2, sc2, g2 = jnp.split(c_lat @ w_mod[i] + b_mod[i], 6, axis=-1)
        mod_c = jnp.split(c_con @ w_mod[i] + b_mod[i], 6, axis=-1)
        a = -jnp.exp(a_log[i].astype(jnp.float32))
        mix_args = (conv_w[i], ssd_conv_w[i], ssd_conv_b[i], dt_bias[i], a, ssd_d[i],
                    ssd_norm_w[i], w_out[i])
        uc = hc * (1.0 + mod_c[1]) + mod_c[0]
        proj_c = uc @ (w_in[i][:, XBC_OFF:] if last else w_in[i])
        xs_c, bm_c, _, dt_c = ssd_inputs(proj_c[..., -SSD_TAIL:], ssd_conv_w[i], ssd_conv_b[i],
                                         dt_bias[i], False)
        fl = lambda t: jnp.flip(t, 1)
        h0_f = ssd_final_state(xs_c, dt_c[:, :, 0], a[0], bm_c)
        h0_b = ssd_final_state(fl(xs_c), fl(dt_c[:, :, 1]), a[1], fl(bm_c))
        u = h * (1.0 + sc1) + sh1
        mix = mixer_out(u @ w_in[i], h0_f, h0_b, True, *mix_args)
        h = layer_norm(alpha * h + g1 * mix, ln1_g[i], ln1_b[i])
        u2 = h * (1.0 + sc2) + sh2
        h = layer_norm(alpha * h + g2 * sq_relu_mlp(u2, w_ff1[i], w_ff2[i]), ln2_g[i], ln2_b[i])
        if not last:
            zeros = jnp.zeros_like(h0_f)
            mix_c = mixer_out(proj_c, zeros, zeros, False, *mix_args)
            hc = layer_norm(alpha * hc + mod_c[2] * mix_c, ln1_g[i], ln1_b[i])
            uc2 = hc * (1.0 + mod_c[4]) + mod_c[3]
            hc = layer_norm(alpha * hc + mod_c[5] * sq_relu_mlp(uc2, w_ff1[i], w_ff2[i]),
                            ln2_g[i], ln2_b[i])
    return h
```

```cpp
#include <hip/hip_runtime.h>
#include <hip/hip_cooperative_groups.h>
#include <cstdio>
#include <cstdint>
namespace cg = cooperative_groups;

#ifndef ONE_LAUNCH
#define ONE_LAUNCH 1
#endif

constexpr int D = 1024, NBATCH = 8, SEQ = 2048, CTXL = 256;
constexpr int MLAT = NBATCH * SEQ, MCTX = NBATCH * CTXL, MALL = MLAT + MCTX;
constexpr int IN_DIM = 3088, NPROJ = 3072, FF = 4096;
constexpr int CONVW = 512, SSDW = 512, XBC = 1024, NH = 8, HD = 64, NS = 128;
constexpr int Z_OFF = 1536, XBC_OFF = 2048;
constexpr float LN_EPS = 1e-5f, RMS_EPS = 1e-5f, ALPHA = 1.189207115002721f;
constexpr int NT = 512, NWAVES = 8, NPHASES = 11;

constexpr size_t MiB = 1u << 20;
constexpr size_t WS_MOD = 0, WS_STATS = 256 * 1024;
constexpr size_t WS_WIN_T = 1 * MiB, WS_WDT_T = 7 * MiB, WS_WOUT_T = 8 * MiB, WS_WFF1_T = 10 * MiB, WS_WFF2_T = 18 * MiB;
constexpr size_t WS_U = 26 * MiB, WS_YDIR = 26 * MiB, WS_U2 = 26 * MiB;
constexpr size_t WS_PROJ = 62 * MiB, WS_V1PRE = 62 * MiB, WS_ACT = 62 * MiB;
constexpr size_t WS_XBC = 170 * MiB, WS_DT = 206 * MiB, WS_MERGED = 208 * MiB, WS_H1 = 208 * MiB;
constexpr size_t WS_END = 240 * MiB;
constexpr int LDS_BYTES = 147456;

typedef unsigned short bf16;
typedef unsigned v4u __attribute__((ext_vector_type(4)));
typedef unsigned v2u __attribute__((ext_vector_type(2)));
typedef float f32x4 __attribute__((ext_vector_type(4)));

__device__ __forceinline__ float bf2f(unsigned v) { return __uint_as_float(v << 16); }
__device__ __forceinline__ float bflo(unsigned w) { return __uint_as_float(w << 16); }
__device__ __forceinline__ float bfhi(unsigned w) { return __uint_as_float(w & 0xffff0000u); }
__device__ __forceinline__ unsigned f2bf(float f) { unsigned u = __float_as_uint(f); return (u + 0x7fffu + ((u >> 16) & 1u)) >> 16; }
__device__ __forceinline__ unsigned pk2(float lo, float hi) { return f2bf(lo) | (f2bf(hi) << 16); }
__device__ __forceinline__ float wave_sum(float v) {
#pragma unroll
    for (int o = 1; o < 64; o <<= 1) v += __shfl_xor(v, o);
    return v;
}
__device__ __forceinline__ float silu_f(float v) { return v / (1.f + __expf(-v)); }
__device__ __forceinline__ float softplus_f(float v) { return v > 20.f ? v : log1pf(__expf(v)); }

struct Args { const float* in[23]; float* out; unsigned char* ws; int ph_lo, ph_hi; };
enum { I_X = 0, I_C, I_CTX, I_CCTX, I_LNG, I_LNB, I_WMOD, I_BMOD, I_WIN, I_CONVW, I_SCW, I_SCB, I_DTB, I_ALOG, I_SSDD, I_SNW, I_WOUT,
       I_LN1G, I_LN1B, I_WFF1, I_WFF2, I_LN2G, I_LN2B };

__device__ __forceinline__ void transpose_item(const float* W, int ldw, int K, int N, bf16* WT, float* scr, int item, int lane) {
    const int nblk = N / 32, kb = item / nblk, nb = item % nblk, k0 = 64 * kb, n0 = 32 * nb;
#pragma unroll 8
    for (int i = 0; i < 32; ++i) { const int kk = 2 * i + (lane >> 5); scr[kk * 33 + (lane & 31)] = W[(size_t)(k0 + kk) * ldw + n0 + (lane & 31)]; }
    __builtin_amdgcn_s_waitcnt(0); __builtin_amdgcn_wave_barrier();
    const int c = lane & 7;
#pragma unroll
    for (int j = 0; j < 4; ++j) { const int n = (lane >> 3) + 8 * j; const float* s = scr + (8 * c) * 33 + n;
        v4u o; o.x = pk2(s[0 * 33], s[1 * 33]); o.y = pk2(s[2 * 33], s[3 * 33]); o.z = pk2(s[4 * 33], s[5 * 33]); o.w = pk2(s[6 * 33], s[7 * 33]);
        *(v4u*)(WT + (size_t)(n0 + n) * K + k0 + 8 * c) = o; }
    __builtin_amdgcn_s_waitcnt(0); __builtin_amdgcn_wave_barrier();
}

__device__ __forceinline__ void phase_p0a(const Args& a, unsigned char* lds, int bid, int nb) {
    const int tid = threadIdx.x, lane = tid & 63, wave = tid >> 6;
    unsigned char* ws = a.ws;
    if (bid < 96) {
        float* sC = (float*)lds;
        float* part = (float*)(lds + 40960);
        for (int i = tid; i < 9 * 1024; i += NT) { const int r = i >> 10, k = i & 1023; const float v = r < 8 ? a.in[I_C][r * 1024 + k] : a.in[I_CCTX][k]; sC[i] = silu_f(v); }
        __syncthreads();
        float* MOD = (float*)(ws + WS_MOD);
        for (int item = bid; item < 96; item += nb) {
            const int j = item * 64 + lane, k0 = wave * 128;
            float acc[9];
#pragma unroll
            for (int r = 0; r < 9; ++r) acc[r] = 0.f;
            const float* wm = a.in[I_WMOD];
#pragma unroll 4
            for (int k = k0; k < k0 + 128; ++k) { const float w = wm[(size_t)k * 6144 + j];
#pragma unroll
                for (int r = 0; r < 9; ++r) acc[r] += sC[r * 1024 + k] * w; }
#pragma unroll
            for (int r = 0; r < 9; ++r) part[(wave * 9 + r) * 64 + lane] = acc[r];
            __syncthreads();
            for (int idx = tid; idx < 576; idx += NT) { const int r = idx >> 6, l = idx & 63; float s = a.in[I_BMOD][item * 64 + l];
#pragma unroll
                for (int w = 0; w < 8; ++w) s += part[(w * 9 + r) * 64 + l];
                MOD[r * 6144 + item * 64 + l] = s; }
            __syncthreads();
        }
    }
    __syncthreads();
    { bf16* WDT = (bf16*)(ws + WS_WDT_T);
      for (int i = bid * NT + tid; i < 16 * 1024; i += nb * NT) { const int j = i >> 10, k = i & 1023; WDT[i] = (bf16)f2bf(a.in[I_WIN][(size_t)k * IN_DIM + NPROJ + j]); } }
    float* scr = (float*)(lds + wave * 16384);
    const int gw = bid * NWAVES + wave, NGW = nb * NWAVES;
    constexpr int IT_IN = 16 * 96, IT_OUT = 16 * 32, IT_F1 = 16 * 128, IT_F2 = 64 * 32, IT_ALL = IT_IN + IT_OUT + IT_F1 + IT_F2;
    for (int it = gw; it < IT_ALL; it += NGW) {
        int r = it;
        if (r < IT_IN) { transpose_item(a.in[I_WIN], IN_DIM, D, NPROJ, (bf16*)(ws + WS_WIN_T), scr, r, lane); continue; } r -= IT_IN;
        if (r < IT_OUT) { transpose_item(a.in[I_WOUT], D, D, D, (bf16*)(ws + WS_WOUT_T), scr, r, lane); continue; } r -= IT_OUT;
        if (r < IT_F1) { transpose_item(a.in[I_WFF1], FF, D, FF, (bf16*)(ws + WS_WFF1_T), scr, r, lane); continue; } r -= IT_F1;
        transpose_item(a.in[I_WFF2], D, FF, D, (bf16*)(ws + WS_WFF2_T), scr, r, lane);
    }
}

__device__ __forceinline__ void phase_p0b(const Args& a, int bid, int nb) {
    const int tid = threadIdx.x, lane = tid & 63, wave = tid >> 6;
    const int gw = bid * NWAVES + wave, NGW = nb * NWAVES;
    const float* MOD = (const float*)(a.ws + WS_MOD);
    float* STATS = (float*)(a.ws + WS_STATS);
    bf16* U = (bf16*)(a.ws + WS_U);
    for (int row = gw; row < MALL; row += NGW) {
        const float* src = row < MLAT ? a.in[I_X] + (size_t)row * D : a.in[I_CTX] + (size_t)(row - MLAT) * D;
        const int r = row < MLAT ? row / SEQ : 8;
        const f32x4* xr = (const f32x4*)src + lane;
        f32x4 v[4]; float s = 0.f;
#pragma unroll
        for (int j = 0; j < 4; ++j) { v[j] = xr[64 * j]; s += (v[j].x + v[j].y) + (v[j].z + v[j].w); }
        const float mean = wave_sum(s) * (1.f / D); float s2 = 0.f;
#pragma unroll
        for (int j = 0; j < 4; ++j) { v[j] = v[j] - mean; s2 += (v[j].x * v[j].x + v[j].y * v[j].y) + (v[j].z * v[j].z + v[j].w * v[j].w); }
        const float rstd = 1.f / sqrtf(wave_sum(s2) * (1.f / D) + LN_EPS);
        if (lane == 0) { STATS[2 * row] = mean; STATS[2 * row + 1] = rstd; }
        v2u* o8 = (v2u*)(U + (size_t)row * D) + lane;
#pragma unroll
        for (int j = 0; j < 4; ++j) {
            const int c = 4 * (lane + 64 * j);
            const f32x4 g = *(const f32x4*)(a.in[I_LNG] + c), bb = *(const f32x4*)(a.in[I_LNB] + c);
            const f32x4 sh = *(const f32x4*)(MOD + r * 6144 + c), sc = *(const f32x4*)(MOD + r * 6144 + 1024 + c);
            const f32x4 h = v[j] * rstd * g + bb;
            const f32x4 u = h * (1.f + sc) + sh;
            v2u w; w.x = pk2(u.x, u.y); w.y = pk2(u.z, u.w); o8[64 * j] = w;
        }
    }
}

template <class Epi, class Ok>
__device__ __forceinline__ void gemm_naive(unsigned char* lds, const bf16* A, const bf16* Bt, int M, int N, int K, int bid, int nb, const Epi& epi, const Ok& ok) {
    float* As = (float*)lds; float* Bs = As + 64 * 33;
    const int tid = threadIdx.x, row = tid >> 3, cgp = tid & 7;
    const int tilesN = N / 64, ntiles = (M / 64) * tilesN;
    for (int tile = bid; tile < ntiles; tile += nb) {
        const int tm = tile / tilesN, tn = tile % tilesN;
        if (!ok(tm, tn)) continue;
        float acc[8];
#pragma unroll
        for (int j = 0; j < 8; ++j) acc[j] = 0.f;
        for (int k0 = 0; k0 < K; k0 += 32) {
            const int r = tid >> 3, c4 = (tid & 7) * 4;
            const v2u av = *(const v2u*)(A + (size_t)(tm * 64 + r) * K + k0 + c4);
            const v2u bv = *(const v2u*)(Bt + (size_t)(tn * 64 + r) * K + k0 + c4);
            __syncthreads();
            As[r * 33 + c4 + 0] = bflo(av.x); As[r * 33 + c4 + 1] = bfhi(av.x); As[r * 33 + c4 + 2] = bflo(av.y); As[r * 33 + c4 + 3] = bfhi(av.y);
            Bs[r * 33 + c4 + 0] = bflo(bv.x); Bs[r * 33 + c4 + 1] = bfhi(bv.x); Bs[r * 33 + c4 + 2] = bflo(bv.y); Bs[r * 33 + c4 + 3] = bfhi(bv.y);
            __syncthreads();
#pragma unroll 8
            for (int k = 0; k < 32; ++k) { const float av1 = As[row * 33 + k];
#pragma unroll
                for (int j = 0; j < 8; ++j) acc[j] += av1 * Bs[(cgp * 8 + j) * 33 + k]; }
        }
#pragma unroll
        for (int j = 0; j < 8; ++j) epi(tm * 64 + row, tn * 64 + cgp * 8 + j, acc[j]);
    }
}

__device__ __forceinline__ void phase_conv(const Args& a, int bid, int nb) {
    const int tid = threadIdx.x, lane = tid & 63, wave = tid >> 6;
    const int gw = bid * NWAVES + wave, NGW = nb * NWAVES;
    const bf16* PROJ = (const bf16*)(a.ws + WS_PROJ);
    const bf16* U = (const bf16*)(a.ws + WS_U);
    const bf16* WDT = (const bf16*)(a.ws + WS_WDT_T);
    bf16* XB = (bf16*)(a.ws + WS_XBC);
    bf16* MG = (bf16*)(a.ws + WS_MERGED);
    float* DT = (float*)(a.ws + WS_DT);
    const float* scw = a.in[I_SCW]; const float* scb = a.in[I_SCB]; const float* cw = a.in[I_CONVW];
    for (int row = gw; row < MALL; row += NGW) {
        const bool lat = row < MLAT;
        const int pos = lat ? (row & 63) : ((row - MLAT) & 255), len = lat ? 64 : 256;
        const bool hasL = pos > 0, hasR = pos < len - 1;
        const bf16* P = PROJ + (size_t)row * NPROJ;
#pragma unroll
        for (int half = 0; half < 2; ++half) {
            const int ch0 = lane * 16 + half * 8;
            if (!lat && ch0 >= 768) continue;
            const v4u zc = {0u, 0u, 0u, 0u};
            const v4u cu = *(const v4u*)(P + XBC_OFF + ch0);
            const v4u le = hasL ? *(const v4u*)(P - NPROJ + XBC_OFF + ch0) : zc;
            const v4u ri = hasR ? *(const v4u*)(P + NPROJ + XBC_OFF + ch0) : zc;
            float o[8];
#pragma unroll
            for (int i = 0; i < 8; ++i) {
                const unsigned wc = i < 2 ? cu.x : i < 4 ? cu.y : i < 6 ? cu.z : cu.w;
                const unsigned wl = i < 2 ? le.x : i < 4 ? le.y : i < 6 ? le.z : le.w;
                const unsigned wr = i < 2 ? ri.x : i < 4 ? ri.y : i < 6 ? ri.z : ri.w;
                const float c = (i & 1) ? bfhi(wc) : bflo(wc), l = (i & 1) ? bfhi(wl) : bflo(wl), r = (i & 1) ? bfhi(wr) : bflo(wr);
                const int ch = ch0 + i;
                const float v = scw[ch] * l + scw[XBC + ch] * c + scw[2 * XBC + ch] * r + scb[ch];
                o[i] = silu_f(v);
            }
            v4u w; w.x = pk2(o[0], o[1]); w.y = pk2(o[2], o[3]); w.z = pk2(o[4], o[5]); w.w = pk2(o[6], o[7]);
            *(v4u*)(XB + (size_t)row * XBC + ch0) = w;
        }
        if (lat) {
            const int ch0 = lane * 8;
            const v4u zc = {0u, 0u, 0u, 0u};
            const v4u gb = *(const v4u*)(P + ch0);
            const v4u gc0 = *(const v4u*)(P + CONVW + ch0), gh0 = *(const v4u*)(P + 2 * CONVW + ch0);
            const v4u gcl = hasL ? *(const v4u*)(P - NPROJ + CONVW + ch0) : zc, ghl = hasL ? *(const v4u*)(P - NPROJ + 2 * CONVW + ch0) : zc;
            const v4u gcr = hasR ? *(const v4u*)(P + NPROJ + CONVW + ch0) : zc, ghr = hasR ? *(const v4u*)(P + NPROJ + 2 * CONVW + ch0) : zc;
            float o[8];
#pragma unroll
            for (int i = 0; i < 8; ++i) {
#define SEL(v) ((i & 1) ? bfhi(i < 2 ? v.x : i < 4 ? v.y : i < 6 ? v.z : v.w) : bflo(i < 2 ? v.x : i < 4 ? v.y : i < 6 ? v.z : v.w))
                const int ch = ch0 + i;
                const float pl = SEL(gcl) * SEL(ghl), pc = SEL(gc0) * SEL(gh0), pr = SEL(gcr) * SEL(ghr);
                o[i] = SEL(gb) * (cw[ch] * pl + cw[CONVW + ch] * pc + cw[2 * CONVW + ch] * pr);
#undef SEL
            }
            v4u w; w.x = pk2(o[0], o[1]); w.y = pk2(o[2], o[3]); w.z = pk2(o[4], o[5]); w.w = pk2(o[6], o[7]);
            *(v4u*)(MG + (size_t)row * D + ch0) = w;
        }
        {
            const v4u u0 = *(const v4u*)(U + (size_t)row * D + lane * 16), u1 = *(const v4u*)(U + (size_t)row * D + lane * 16 + 8);
            float uf[16];
            uf[0] = bflo(u0.x); uf[1] = bfhi(u0.x); uf[2] = bflo(u0.y); uf[3] = bfhi(u0.y); uf[4] = bflo(u0.z); uf[5] = bfhi(u0.z); uf[6] = bflo(u0.w); uf[7] = bfhi(u0.w);
            uf[8] = bflo(u1.x); uf[9] = bfhi(u1.x); uf[10] = bflo(u1.y); uf[11] = bfhi(u1.y); uf[12] = bflo(u1.z); uf[13] = bfhi(u1.z); uf[14] = bflo(u1.w); uf[15] = bfhi(u1.w);
            float mine = 0.f;
#pragma unroll
            for (int j = 0; j < 16; ++j) {
                const v4u w0 = *(const v4u*)(WDT + j * 1024 + lane * 16), w1 = *(const v4u*)(WDT + j * 1024 + lane * 16 + 8);
                float p = uf[0] * bflo(w0.x) + uf[1] * bfhi(w0.x) + uf[2] * bflo(w0.y) + uf[3] * bfhi(w0.y) + uf[4] * bflo(w0.z) + uf[5] * bfhi(w0.z) + uf[6] * bflo(w0.w) + uf[7] * bfhi(w0.w)
                        + uf[8] * bflo(w1.x) + uf[9] * bfhi(w1.x) + uf[10] * bflo(w1.y) + uf[11] * bfhi(w1.y) + uf[12] * bflo(w1.z) + uf[13] * bfhi(w1.z) + uf[14] * bflo(w1.w) + uf[15] * bfhi(w1.w);
                p = wave_sum(p);
                if (lane == j) mine = p;
            }
            if (lane < 16) DT[(size_t)row * 16 + lane] = softplus_f(mine + a.in[I_DTB][lane]);
        }
    }
}

__device__ __forceinline__ void phase_ssd_naive(const Args& a, unsigned char* lds, int bid, int nb) {
    const int tid = threadIdx.x, p = tid >> 3, nq = tid & 7;
    float* sx = (float*)lds;
    float* sB = sx + 64 * 64;
    float* sC = sB + 64 * 128;
    float* sdt = sC + 64 * 128;
    const bf16* XB = (const bf16*)(a.ws + WS_XBC);
    const float* DT = (const float*)(a.ws + WS_DT);
    bf16* YD = (bf16*)(a.ws + WS_YDIR);
    for (int item = bid; item < NBATCH * 2 * NH; item += nb) {
        const int b = item & 7, dir = (item >> 3) & 1, h = item >> 4, g = h >> 2;
        const float ah = -__expf(a.in[I_ALOG][dir * 8 + h]);
        float S[16];
#pragma unroll
        for (int i = 0; i < 16; ++i) S[i] = 0.f;
        for (int blk = 0; blk < 36; ++blk) {
            const bool isctx = blk < 4;
            int bi = isctx ? blk : blk - 4; const int nblk = isctx ? 4 : 32; if (dir) bi = nblk - 1 - bi;
            const int rowbase = isctx ? MLAT + b * CTXL + bi * 64 : b * SEQ + bi * 64;
            __syncthreads();
            { const int idx = tid * 8, t = idx >> 6, p0 = idx & 63;
              const v4u w = *(const v4u*)(XB + (size_t)(rowbase + t) * XBC + h * 64 + p0); float* d = sx + t * 64 + p0;
              d[0] = bflo(w.x); d[1] = bfhi(w.x); d[2] = bflo(w.y); d[3] = bfhi(w.y); d[4] = bflo(w.z); d[5] = bfhi(w.z); d[6] = bflo(w.w); d[7] = bfhi(w.w); }
#pragma unroll
            for (int it = 0; it < 2; ++it) { const int idx = tid * 8 + it * 4096, t = idx >> 7, n0 = idx & 127;
              { const v4u w = *(const v4u*)(XB + (size_t)(rowbase + t) * XBC + 512 + g * 128 + n0); float* d = sB + t * 128 + n0;
                d[0] = bflo(w.x); d[1] = bfhi(w.x); d[2] = bflo(w.y); d[3] = bfhi(w.y); d[4] = bflo(w.z); d[5] = bfhi(w.z); d[6] = bflo(w.w); d[7] = bfhi(w.w); }
              if (!isctx) { const v4u w = *(const v4u*)(XB + (size_t)(rowbase + t) * XBC + 768 + g * 128 + n0); float* d = sC + t * 128 + n0;
                d[0] = bflo(w.x); d[1] = bfhi(w.x); d[2] = bflo(w.y); d[3] = bfhi(w.y); d[4] = bflo(w.z); d[5] = bfhi(w.z); d[6] = bflo(w.w); d[7] = bfhi(w.w); } }
            if (tid < 64) sdt[tid] = DT[(size_t)(rowbase + tid) * 16 + dir * 8 + h];
            __syncthreads();
            for (int tt = 0; tt < 64; ++tt) {
                const int t = dir ? 63 - tt : tt;
                const float dtv = sdt[t], dA = __expf(dtv * ah), xv = sx[t * 64 + p] * dtv;
                float y = 0.f;
#pragma unroll
                for (int i = 0; i < 16; ++i) { S[i] = dA * S[i] + xv * sB[t * 128 + nq * 16 + i]; if (!isctx) y += S[i] * sC[t * 128 + nq * 16 + i]; }
                if (!isctx) {
                    y += __shfl_xor(y, 1); y += __shfl_xor(y, 2); y += __shfl_xor(y, 4);
                    if (nq == 0) YD[(size_t)dir * MLAT * SSDW + (size_t)(rowbase + t) * SSDW + h * 64 + p] = (bf16)f2bf(y);
                }
            }
        }
    }
}

__device__ __forceinline__ void phase_fin(const Args& a, int bid, int nb) {
    const int tid = threadIdx.x, lane = tid & 63, wave = tid >> 6;
    const int gw = bid * NWAVES + wave, NGW = nb * NWAVES;
    const bf16* PROJ = (const bf16*)(a.ws + WS_PROJ);
    const bf16* XB = (const bf16*)(a.ws + WS_XBC);
    const bf16* YD = (const bf16*)(a.ws + WS_YDIR);
    bf16* MG = (bf16*)(a.ws + WS_MERGED);
    for (int row = gw; row < MLAT; row += NGW) {
        const int ch0 = lane * 8;
        const v4u yf = *(const v4u*)(YD + (size_t)row * SSDW + ch0), yb = *(const v4u*)(YD + (size_t)MLAT * SSDW + (size_t)row * SSDW + ch0);
        const v4u xs = *(const v4u*)(XB + (size_t)row * XBC + ch0), zz = *(const v4u*)(PROJ + (size_t)row * NPROJ + Z_OFF + ch0);
        const float dd = a.in[I_SSDD][ch0 >> 6];
        float o[8]; float ss = 0.f;
#pragma unroll
        for (int i = 0; i < 8; ++i) {
#define SEL(v) ((i & 1) ? bfhi(i < 2 ? v.x : i < 4 ? v.y : i < 6 ? v.z : v.w) : bflo(i < 2 ? v.x : i < 4 ? v.y : i < 6 ? v.z : v.w))
            const float y = SEL(yf) + SEL(yb) + SEL(xs) * dd;
            const float yg = y * silu_f(SEL(zz));
#undef SEL
            o[i] = yg; ss += yg * yg;
        }
        const float r = rsqrtf(wave_sum(ss) * (1.f / SSDW) + RMS_EPS);
        const float* nw = a.in[I_SNW] + ch0;
        v4u w; w.x = pk2(o[0] * r * nw[0], o[1] * r * nw[1]); w.y = pk2(o[2] * r * nw[2], o[3] * r * nw[3]);
        w.z = pk2(o[4] * r * nw[4], o[5] * r * nw[5]); w.w = pk2(o[6] * r * nw[6], o[7] * r * nw[7]);
        *(v4u*)(MG + (size_t)row * D + SSDW + ch0) = w;
    }
}

__device__ __forceinline__ void phase_ln1(const Args& a, int bid, int nb) {
    const int tid = threadIdx.x, lane = tid & 63, wave = tid >> 6;
    const int gw = bid * NWAVES + wave, NGW = nb * NWAVES;
    const float* MOD = (const float*)(a.ws + WS_MOD);
    const float* V = (const float*)(a.ws + WS_V1PRE);
    bf16* H1 = (bf16*)(a.ws + WS_H1); bf16* U2 = (bf16*)(a.ws + WS_U2);
    for (int row = gw; row < MLAT; row += NGW) {
        const int r = row / SEQ;
        const f32x4* xr = (const f32x4*)(V + (size_t)row * D) + lane;
        f32x4 v[4]; float s = 0.f;
#pragma unroll
        for (int j = 0; j < 4; ++j) { v[j] = xr[64 * j]; s += (v[j].x + v[j].y) + (v[j].z + v[j].w); }
        const float mean = wave_sum(s) * (1.f / D); float s2 = 0.f;
#pragma unroll
        for (int j = 0; j < 4; ++j) { v[j] = v[j] - mean; s2 += (v[j].x * v[j].x + v[j].y * v[j].y) + (v[j].z * v[j].z + v[j].w * v[j].w); }
        const float rstd = 1.f / sqrtf(wave_sum(s2) * (1.f / D) + LN_EPS);
        v2u* oh = (v2u*)(H1 + (size_t)row * D) + lane; v2u* ou = (v2u*)(U2 + (size_t)row * D) + lane;
#pragma unroll
        for (int j = 0; j < 4; ++j) {
            const int c = 4 * (lane + 64 * j);
            const f32x4 g = *(const f32x4*)(a.in[I_LN1G] + c), bb = *(const f32x4*)(a.in[I_LN1B] + c);
            const f32x4 sh = *(const f32x4*)(MOD + r * 6144 + 3072 + c), sc = *(const f32x4*)(MOD + r * 6144 + 4096 + c);
            const f32x4 h = v[j] * rstd * g + bb;
            const f32x4 u = h * (1.f + sc) + sh;
            v2u w; w.x = pk2(h.x, h.y); w.y = pk2(h.z, h.w); oh[64 * j] = w;
            v2u w2; w2.x = pk2(u.x, u.y); w2.y = pk2(u.z, u.w); ou[64 * j] = w2;
        }
    }
}
__device__ __forceinline__ void phase_ln2(const Args& a, int bid, int nb) {
    const int tid = threadIdx.x, lane = tid & 63, wave = tid >> 6;
    const int gw = bid * NWAVES + wave, NGW = nb * NWAVES;
    for (int row = gw; row < MLAT; row += NGW) {
        f32x4* xr = (f32x4*)(a.out + (size_t)row * D) + lane;
        f32x4 v[4]; float s = 0.f;
#pragma unroll
        for (int j = 0; j < 4; ++j) { v[j] = xr[64 * j]; s += (v[j].x + v[j].y) + (v[j].z + v[j].w); }
        const float mean = wave_sum(s) * (1.f / D); float s2 = 0.f;
#pragma unroll
        for (int j = 0; j < 4; ++j) { v[j] = v[j] - mean; s2 += (v[j].x * v[j].x + v[j].y * v[j].y) + (v[j].z * v[j].z + v[j].w * v[j].w); }
        const float rstd = 1.f / sqrtf(wave_sum(s2) * (1.f / D) + LN_EPS);
#pragma unroll
        for (int j = 0; j < 4; ++j) {
            const int c = 4 * (lane + 64 * j);
            const f32x4 g = *(const f32x4*)(a.in[I_LN2G] + c), bb = *(const f32x4*)(a.in[I_LN2B] + c);
            xr[64 * j] = v[j] * rstd * g + bb;
        }
    }
}

__global__ void __launch_bounds__(NT, 2) mk_fwd(Args a) {
    extern __shared__ __attribute__((aligned(16))) unsigned char lds[];
    const int bid = blockIdx.x, nb = gridDim.x;
    const int lo = a.ph_lo, hi = a.ph_hi;
    unsigned char* ws = a.ws;
#define IN(k) (lo <= (k) && (k) < hi)
#define SEAM(k) do { if (IN(k) && IN((k) + 1)) { cg::this_grid().sync(); } } while (0)
    if (IN(0)) phase_p0a(a, lds, bid, nb);
    SEAM(0);
    if (IN(1)) phase_p0b(a, bid, nb);
    SEAM(1);
    if (IN(2)) {
        bf16* PROJ = (bf16*)(ws + WS_PROJ);
        auto epi = [=](int row, int col, float v) { PROJ[(size_t)row * NPROJ + col] = (bf16)f2bf(v); };
        auto ok = [=](int tm, int tn) { return tm < MLAT / 64 || (tn >= 32 && tn < 44); };
        gemm_naive(lds, (const bf16*)(ws + WS_U), (const bf16*)(ws + WS_WIN_T), MALL, NPROJ, D, bid, nb, epi, ok);
    }
    SEAM(2);
    if (IN(3)) phase_conv(a, bid, nb);
    SEAM(3);
    if (IN(4)) phase_ssd_naive(a, lds, bid, nb);
    SEAM(4);
    if (IN(5)) phase_fin(a, bid, nb);
    SEAM(5);
    if (IN(6)) {
        float* V = (float*)(ws + WS_V1PRE); const float* MOD = (const float*)(ws + WS_MOD); const float* ST = (const float*)(ws + WS_STATS);
        const float* x = a.in[I_X]; const float* lg = a.in[I_LNG]; const float* lb = a.in[I_LNB];
        auto epi = [=](int row, int col, float v) { const int b = row / SEQ; const float h = (x[(size_t)row * D + col] - ST[2 * row]) * ST[2 * row + 1] * lg[col] + lb[col];
            V[(size_t)row * D + col] = ALPHA * h + MOD[b * 6144 + 2048 + col] * v; };
        auto ok = [=](int, int) { return true; };
        gemm_naive(lds, (const bf16*)(ws + WS_MERGED), (const bf16*)(ws + WS_WOUT_T), MLAT, D, D, bid, nb, epi, ok);
    }
    SEAM(6);
    if (IN(7)) phase_ln1(a, bid, nb);
    SEAM(7);
    if (IN(8)) {
        bf16* ACT = (bf16*)(ws + WS_ACT);
        auto epi = [=](int row, int col, float v) { const float r = v > 0.f ? v : 0.f; ACT[(size_t)row * FF + col] = (bf16)f2bf(r * r); };
        auto ok = [=](int, int) { return true; };
        gemm_naive(lds, (const bf16*)(ws + WS_U2), (const bf16*)(ws + WS_WFF1_T), MLAT, FF, D, bid, nb, epi, ok);
    }
    SEAM(8);
    if (IN(9)) {
        float* O = a.out; const float* MOD = (const float*)(ws + WS_MOD); const bf16* H1 = (const bf16*)(ws + WS_H1);
        auto epi = [=](int row, int col, float v) { const int b = row / SEQ; O[(size_t)row * D + col] = ALPHA * bf2f(H1[(size_t)row * D + col]) + MOD[b * 6144 + 5120 + col] * v; };
        auto ok = [=](int, int) { return true; };
        gemm_naive(lds, (const bf16*)(ws + WS_ACT), (const bf16*)(ws + WS_WFF2_T), MLAT, D, FF, bid, nb, epi, ok);
    }
    SEAM(9);
    if (IN(10)) phase_ln2(a, bid, nb);
#undef IN
#undef SEAM
}

extern "C" void kernel_launch(void* const* d_in, const int* in_sizes, int n_in, void* d_out, int out_size, void* d_ws, size_t ws_size, hipStream_t stream) {
    static int grid = 0;
    if (grid == 0) {
        if (n_in != 23 || out_size != MLAT * D || ws_size < WS_END) { fprintf(stderr, "kernel_launch: unexpected shapes n_in %d out %d ws %zu\n", n_in, out_size, ws_size); grid = -1; return; }
        int dev = 0, cus = 0, per_cu = 0;
        (void)hipGetDevice(&dev);
        (void)hipDeviceGetAttribute(&cus, hipDeviceAttributeMultiprocessorCount, dev);
        (void)hipFuncSetAttribute((const void*)mk_fwd, hipFuncAttributeMaxDynamicSharedMemorySize, LDS_BYTES);
        (void)hipOccupancyMaxActiveBlocksPerMultiprocessor(&per_cu, (const void*)mk_fwd, NT, LDS_BYTES);
        (void)hipGetLastError();
        if (per_cu < 1) { fprintf(stderr, "kernel_launch: occupancy query says %d blocks/CU\n", per_cu); per_cu = 1; }
        grid = cus;
    }
    if (grid < 0) return;
    Args a{};
    for (int i = 0; i < 23; ++i) a.in[i] = (const float*)d_in[i];
    a.out = (float*)d_out; a.ws = (unsigned char*)d_ws;
#if ONE_LAUNCH
    a.ph_lo = 0; a.ph_hi = NPHASES;
    void* args[] = {&a};
    hipError_t e = hipLaunchCooperativeKernel((const void*)mk_fwd, dim3(grid), dim3(NT), args, LDS_BYTES, stream);
    if (e != hipSuccess) fprintf(stderr, "cooperative launch failed: %s (grid %d)\n", hipGetErrorString(e), grid);
#else
    for (int ph = 0; ph < NPHASES; ++ph) {
        a.ph_lo = ph; a.ph_hi = ph + 1;
        hipLaunchKernelGGL(mk_fwd, dim3(grid), dim3(NT), LDS_BYTES, stream, a);
    }
#endif
}
```

```cpp
#include <hip/hip_runtime.h>
#include <hip/hip_cooperative_groups.h>
#include <cstdio>
#include <cstdint>
namespace cg = cooperative_groups;

#ifndef ONE_LAUNCH
#define ONE_LAUNCH 1
#endif

constexpr int D = 1024, NBATCH = 8, SEQ = 2048, CTXL = 256;
constexpr int MLAT = NBATCH * SEQ, MCTX = NBATCH * CTXL, MALL = MLAT + MCTX;
constexpr int IN_DIM = 3088, NPROJ = 3072, FF = 4096;
constexpr int CONVW = 512, SSDW = 512, XBC = 1024, NH = 8, HD = 64, NS = 128;
constexpr int Z_OFF = 1536, XBC_OFF = 2048;
constexpr float LN_EPS = 1e-5f, RMS_EPS = 1e-5f, ALPHA = 1.189207115002721f;
constexpr int NT = 512, NWAVES = 8, NPHASES = 11;

constexpr size_t MiB = 1u << 20;
constexpr size_t WS_MOD = 0, WS_STATS = 256 * 1024;
constexpr size_t WS_WIN_T = 1 * MiB, WS_WDT_T = 7 * MiB, WS_WOUT_T = 8 * MiB, WS_WFF1_T = 10 * MiB, WS_WFF2_T = 18 * MiB;
constexpr size_t WS_U = 26 * MiB, WS_YDIR = 26 * MiB, WS_U2 = 26 * MiB;
constexpr size_t WS_PROJ = 62 * MiB, WS_V1PRE = 62 * MiB, WS_ACT = 62 * MiB;
constexpr size_t WS_XBC = 170 * MiB, WS_DT = 206 * MiB, WS_MERGED = 208 * MiB, WS_H1 = 208 * MiB;
constexpr size_t WS_END = 240 * MiB;
constexpr int LDS_BYTES = 147456;

typedef unsigned short bf16;
#define LAS __attribute__((address_space(3)))
typedef unsigned v4u __attribute__((ext_vector_type(4)));
typedef unsigned v2u __attribute__((ext_vector_type(2)));
typedef float f32x4 __attribute__((ext_vector_type(4)));

__device__ __forceinline__ float bf2f(unsigned v) { return __uint_as_float(v << 16); }
__device__ __forceinline__ float bflo(unsigned w) { return __uint_as_float(w << 16); }
__device__ __forceinline__ float bfhi(unsigned w) { return __uint_as_float(w & 0xffff0000u); }
__device__ __forceinline__ unsigned f2bf(float f) { unsigned u = __float_as_uint(f); return (u + 0x7fffu + ((u >> 16) & 1u)) >> 16; }
__device__ __forceinline__ unsigned pk2(float lo, float hi) { return f2bf(lo) | (f2bf(hi) << 16); }
__device__ __forceinline__ float wave_sum(float v) {
#pragma unroll
    for (int o = 1; o < 64; o <<= 1) v += __shfl_xor(v, o);
    return v;
}
__device__ __forceinline__ float silu_f(float v) { return v / (1.f + __expf(-v)); }
__device__ __forceinline__ float softplus_f(float v) { return v > 20.f ? v : log1pf(__expf(v)); }

struct Args { const float* in[23]; float* out; unsigned char* ws; int ph_lo, ph_hi; };
enum { I_X = 0, I_C, I_CTX, I_CCTX, I_LNG, I_LNB, I_WMOD, I_BMOD, I_WIN, I_CONVW, I_SCW, I_SCB, I_DTB, I_ALOG, I_SSDD, I_SNW, I_WOUT,
       I_LN1G, I_LN1B, I_WFF1, I_WFF2, I_LN2G, I_LN2B };

__device__ __forceinline__ void transpose_item(const float* W, int ldw, int K, int N, bf16* WT, float* scr, int item, int lane) {
    const int nblk = N / 32, kb = item / nblk, nb = item % nblk, k0 = 64 * kb, n0 = 32 * nb;
#pragma unroll 8
    for (int i = 0; i < 32; ++i) { const int kk = 2 * i + (lane >> 5); scr[kk * 33 + (lane & 31)] = W[(size_t)(k0 + kk) * ldw + n0 + (lane & 31)]; }
    __builtin_amdgcn_s_waitcnt(0); __builtin_amdgcn_wave_barrier();
    const int c = lane & 7;
#pragma unroll
    for (int j = 0; j < 4; ++j) { const int n = (lane >> 3) + 8 * j; const float* s = scr + (8 * c) * 33 + n;
        v4u o; o.x = pk2(s[0 * 33], s[1 * 33]); o.y = pk2(s[2 * 33], s[3 * 33]); o.z = pk2(s[4 * 33], s[5 * 33]); o.w = pk2(s[6 * 33], s[7 * 33]);
        *(v4u*)(WT + (size_t)(n0 + n) * K + k0 + 8 * c) = o; }
    __builtin_amdgcn_s_waitcnt(0); __builtin_amdgcn_wave_barrier();
}

__device__ __forceinline__ void phase_p0a(const Args& a, unsigned char* lds, int bid, int nb) {
    const int tid = threadIdx.x, lane = tid & 63, wave = tid >> 6;
    unsigned char* ws = a.ws;
    if (bid < 96) {
        float* sC = (float*)lds;
        float* part = (float*)(lds + 40960);
        for (int i = tid; i < 9 * 1024; i += NT) { const int r = i >> 10, k = i & 1023; const float v = r < 8 ? a.in[I_C][r * 1024 + k] : a.in[I_CCTX][k]; sC[i] = silu_f(v); }
        __syncthreads();
        float* MOD = (float*)(ws + WS_MOD);
        for (int item = bid; item < 96; item += nb) {
            const int j = item * 64 + lane, k0 = wave * 128;
            float acc[9];
#pragma unroll
            for (int r = 0; r < 9; ++r) acc[r] = 0.f;
            const float* wm = a.in[I_WMOD];
#pragma unroll 4
            for (int k = k0; k < k0 + 128; ++k) { const float w = wm[(size_t)k * 6144 + j];
#pragma unroll
                for (int r = 0; r < 9; ++r) acc[r] += sC[r * 1024 + k] * w; }
#pragma unroll
            for (int r = 0; r < 9; ++r) part[(wave * 9 + r) * 64 + lane] = acc[r];
            __syncthreads();
            for (int idx = tid; idx < 576; idx += NT) { const int r = idx >> 6, l = idx & 63; float s = a.in[I_BMOD][item * 64 + l];
#pragma unroll
                for (int w = 0; w < 8; ++w) s += part[(w * 9 + r) * 64 + l];
                MOD[r * 6144 + item * 64 + l] = s; }
            __syncthreads();
        }
    }
    __syncthreads();
    { bf16* WDT = (bf16*)(ws + WS_WDT_T);
      for (int i = bid * NT + tid; i < 16 * 1024; i += nb * NT) { const int j = i >> 10, k = i & 1023; WDT[i] = (bf16)f2bf(a.in[I_WIN][(size_t)k * IN_DIM + NPROJ + j]); } }
    float* scr = (float*)(lds + wave * 16384);
    const int gw = bid * NWAVES + wave, NGW = nb * NWAVES;
    constexpr int IT_IN = 16 * 96, IT_OUT = 16 * 32, IT_F1 = 16 * 128, IT_F2 = 64 * 32, IT_ALL = IT_IN + IT_OUT + IT_F1 + IT_F2;
    for (int it = gw; it < IT_ALL; it += NGW) {
        int r = it;
        if (r < IT_IN) { transpose_item(a.in[I_WIN], IN_DIM, D, NPROJ, (bf16*)(ws + WS_WIN_T), scr, r, lane); continue; } r -= IT_IN;
        if (r < IT_OUT) { transpose_item(a.in[I_WOUT], D, D, D, (bf16*)(ws + WS_WOUT_T), scr, r, lane); continue; } r -= IT_OUT;
        if (r < IT_F1) { transpose_item(a.in[I_WFF1], FF, D, FF, (bf16*)(ws + WS_WFF1_T), scr, r, lane); continue; } r -= IT_F1;
        transpose_item(a.in[I_WFF2], D, FF, D, (bf16*)(ws + WS_WFF2_T), scr, r, lane);
    }
}

__device__ __forceinline__ void phase_p0b(const Args& a, int bid, int nb) {
    const int tid = threadIdx.x, lane = tid & 63, wave = tid >> 6;
    const int gw = bid * NWAVES + wave, NGW = nb * NWAVES;
    const float* MOD = (const float*)(a.ws + WS_MOD);
    float* STATS = (float*)(a.ws + WS_STATS);
    bf16* U = (bf16*)(a.ws + WS_U);
    for (int row = gw; row < MALL; row += NGW) {
        const float* src = row < MLAT ? a.in[I_X] + (size_t)row * D : a.in[I_CTX] + (size_t)(row - MLAT) * D;
        const int r = row < MLAT ? row / SEQ : 8;
        const f32x4* xr = (const f32x4*)src + lane;
        f32x4 v[4]; float s = 0.f;
#pragma unroll
        for (int j = 0; j < 4; ++j) { v[j] = xr[64 * j]; s += (v[j].x + v[j].y) + (v[j].z + v[j].w); }
        const float mean = wave_sum(s) * (1.f / D); float s2 = 0.f;
#pragma unroll
        for (int j = 0; j < 4; ++j) { v[j] = v[j] - mean; s2 += (v[j].x * v[j].x + v[j].y * v[j].y) + (v[j].z * v[j].z + v[j].w * v[j].w); }
        const float rstd = 1.f / sqrtf(wave_sum(s2) * (1.f / D) + LN_EPS);
        if (lane == 0) { STATS[2 * row] = mean; STATS[2 * row + 1] = rstd; }
        v2u* o8 = (v2u*)(U + (size_t)row * D) + lane;
#pragma unroll
        for (int j = 0; j < 4; ++j) {
            const int c = 4 * (lane + 64 * j);
            const f32x4 g = *(const f32x4*)(a.in[I_LNG] + c), bb = *(const f32x4*)(a.in[I_LNB] + c);
            const f32x4 sh = *(const f32x4*)(MOD + r * 6144 + c), sc = *(const f32x4*)(MOD + r * 6144 + 1024 + c);
            const f32x4 h = v[j] * rstd * g + bb;
            const f32x4 u = h * (1.f + sc) + sh;
            v2u w; w.x = pk2(u.x, u.y); w.y = pk2(u.z, u.w); o8[64 * j] = w;
        }
    }
}

template <class Epi, class Ok>
__device__ __forceinline__ void gemm_naive(unsigned char* lds, const bf16* A, const bf16* Bt, int M, int N, int K, int bid, int nb, const Epi& epi, const Ok& ok) {
    float* As = (float*)lds; float* Bs = As + 64 * 33;
    const int tid = threadIdx.x, row = tid >> 3, cgp = tid & 7;
    const int tilesN = N / 64, ntiles = (M / 64) * tilesN;
    for (int tile = bid; tile < ntiles; tile += nb) {
        const int tm = tile / tilesN, tn = tile % tilesN;
        if (!ok(tm, tn)) continue;
        float acc[8];
#pragma unroll
        for (int j = 0; j < 8; ++j) acc[j] = 0.f;
        for (int k0 = 0; k0 < K; k0 += 32) {
            const int r = tid >> 3, c4 = (tid & 7) * 4;
            const v2u av = *(const v2u*)(A + (size_t)(tm * 64 + r) * K + k0 + c4);
            const v2u bv = *(const v2u*)(Bt + (size_t)(tn * 64 + r) * K + k0 + c4);
            __syncthreads();
            As[r * 33 + c4 + 0] = bflo(av.x); As[r * 33 + c4 + 1] = bfhi(av.x); As[r * 33 + c4 + 2] = bflo(av.y); As[r * 33 + c4 + 3] = bfhi(av.y);
            Bs[r * 33 + c4 + 0] = bflo(bv.x); Bs[r * 33 + c4 + 1] = bfhi(bv.x); Bs[r * 33 + c4 + 2] = bflo(bv.y); Bs[r * 33 + c4 + 3] = bfhi(bv.y);
            __syncthreads();
#pragma unroll 8
            for (int k = 0; k < 32; ++k) { const float av1 = As[row * 33 + k];
#pragma unroll
                for (int j = 0; j < 8; ++j) acc[j] += av1 * Bs[(cgp * 8 + j) * 33 + k]; }
        }
#pragma unroll
        for (int j = 0; j < 8; ++j) epi(tm * 64 + row, tn * 64 + cgp * 8 + j, acc[j]);
    }
}

namespace pg8 {
#define PG8_LAS __attribute__((address_space(3)))
typedef unsigned short bf16_t;
typedef short bf16x8 __attribute__((ext_vector_type(8)));
typedef float f32x4 __attribute__((ext_vector_type(4)));
typedef unsigned u32x4 __attribute__((ext_vector_type(4)));
constexpr int BM = 256, BK = 64, HALF = 128, HTB = HALF * BK * 2  , STAGE_BYTES = 8 * HTB, NXCD = 8, WGM = 8;

__host__ __device__ __forceinline__ int lds_byte(int r, int c) { const int st = (r >> 4) * 2 + (c >> 5), rr = r & 15, cc = c & 31, ob = rr * 64 + cc * 2; return st * 1024 + (ob ^ (((ob >> 9) & 1) << 5)); }
__host__ __device__ __forceinline__ void stage_rc(int b, int& R, int& C) { const int st = b / 1024, sb = b % 1024, swz = sb ^ (((sb >> 9) & 1) << 5); R = (st >> 1) * 16 + swz / 64; C = (st & 1) * 32 + (swz % 64) / 2; }
__host__ __device__ __forceinline__ int perm32(int rho) { const int n = rho >> 4, i = rho & 15; return 8 * (i >> 2) + 4 * n + (i & 3); }

struct Unit { int pm, pn; };
struct Gemm { const bf16_t* A; const bf16_t* Bt; int M, N, K; };

struct StaticOrder {
    int nM, nN, nwg, G, c;
    __host__ __device__ void init(int M, int N, int G_, int c_) { nM = M / BM; nN = N / BM; nwg = nM * nN; G = G_; c = c_; }
    __host__ __device__ bool next(int i, Unit& u) const {
        const long L = (long)i * G + c; if (L >= nwg) return false;
        int wgid = (int)L; { const int q = nwg / NXCD, r = nwg % NXCD, xcd = wgid % NXCD, off = wgid / NXCD; wgid = (xcd < r ? xcd * (q + 1) : r * (q + 1) + (xcd - r) * q) + off; }
        const int nig = WGM * nN, gid = wgid / nig, fm = gid * WGM, gsz = (nM - fm) < WGM ? (nM - fm) : WGM;
        u.pm = fm + ((wgid % nig) % gsz); u.pn = (wgid % nig) / gsz; return true;
    }
    __device__ __forceinline__ void a_ready(const Unit&) const {}
    __device__ __forceinline__ void done(const Unit&) const {}
};


__device__ __forceinline__ unsigned cvt_pk_bf16(float lo, float hi) { unsigned r; asm volatile("v_cvt_pk_bf16_f32 %0, %1, %2" : "=v"(r) : "v"(lo), "v"(hi)); return r; }
template <int ACT  > struct EpiBf16 {
    static constexpr bool PERM = true, AFTER_DRAIN = false;
    bf16_t* O; int ldc;
    __device__ __forceinline__ void operator()(const f32x4 (&acc)[2][2][4][2], const Unit& u, int wr, int wc, int fr, int fq) const {
        const int row0 = u.pm * BM + wr * 64 + fr; const int col0 = u.pn * BM + wc * 32 + 8 * fq;
#pragma unroll
        for (int ai = 0; ai < 2; ++ai)
#pragma unroll
            for (int m = 0; m < 4; ++m) { bf16_t* rowp = O + (size_t)(row0 + ai * HALF + m * 16) * ldc + col0;
#pragma unroll
                for (int bj = 0; bj < 2; ++bj) { f32x4 v0 = acc[ai][bj][m][0], v1 = acc[ai][bj][m][1];
                    if (ACT == 1) {
#pragma unroll
                        for (int e = 0; e < 4; ++e) { const float a0 = v0[e] > 0.f ? v0[e] : 0.f, a1 = v1[e] > 0.f ? v1[e] : 0.f; v0[e] = a0 * a0; v1[e] = a1 * a1; } }
                    u32x4 w; w.x = cvt_pk_bf16(v0[0], v0[1]); w.y = cvt_pk_bf16(v0[2], v0[3]); w.z = cvt_pk_bf16(v1[0], v1[1]); w.w = cvt_pk_bf16(v1[2], v1[3]);
                    *(u32x4*)(rowp + bj * HALF) = w; } }
    }
};
struct EpiRes1 {
    static constexpr bool PERM = false, AFTER_DRAIN = false;
    const float* x; const float* stats; const float* lng; const float* lnb; const float* modg; float* V; float alpha;
    __device__ __forceinline__ void operator()(const f32x4 (&acc)[2][2][4][2], const Unit& u, int wr, int wc, int fr, int fq) const {
        const int b = u.pm >> 3; const int colb = u.pn * BM + wc * 32 + 4 * fq;
#pragma unroll
        for (int bj = 0; bj < 2; ++bj)
#pragma unroll
            for (int n = 0; n < 2; ++n) { const int col = colb + bj * HALF + n * 16;
                const f32x4 g = *(const f32x4*)(lng + col), bb = *(const f32x4*)(lnb + col), g1 = *(const f32x4*)(modg + b * 6144 + col);
#pragma unroll
                for (int ai = 0; ai < 2; ++ai)
#pragma unroll
                    for (int m = 0; m < 4; ++m) { const int row = u.pm * BM + ai * HALF + wr * 64 + m * 16 + fr;
                        const float mean = stats[2 * row], rstd = stats[2 * row + 1];
                        const f32x4 xv = *(const f32x4*)(x + (size_t)row * 1024 + col);
                        const f32x4 h = (xv - mean) * rstd * g + bb;
                        *(f32x4*)(V + (size_t)row * 1024 + col) = h * alpha + g1 * acc[ai][bj][m][n]; } }
    }
};
struct EpiRes2 {
    static constexpr bool PERM = false, AFTER_DRAIN = false;
    const bf16_t* H1; const float* modg; float* O; float alpha;
    __device__ __forceinline__ void operator()(const f32x4 (&acc)[2][2][4][2], const Unit& u, int wr, int wc, int fr, int fq) const {
        typedef unsigned u32x2 __attribute__((ext_vector_type(2)));
        const int b = u.pm >> 3; const int colb = u.pn * BM + wc * 32 + 4 * fq;
#pragma unroll
        for (int bj = 0; bj < 2; ++bj)
#pragma unroll
            for (int n = 0; n < 2; ++n) { const int col = colb + bj * HALF + n * 16;
                const f32x4 g2 = *(const f32x4*)(modg + b * 6144 + col);
#pragma unroll
                for (int ai = 0; ai < 2; ++ai)
#pragma unroll
                    for (int m = 0; m < 4; ++m) { const int row = u.pm * BM + ai * HALF + wr * 64 + m * 16 + fr;
                        const u32x2 hw = *(const u32x2*)(H1 + (size_t)row * 1024 + col);
                        f32x4 h; h[0] = __uint_as_float(hw.x << 16); h[1] = __uint_as_float(hw.x & 0xffff0000u); h[2] = __uint_as_float(hw.y << 16); h[3] = __uint_as_float(hw.y & 0xffff0000u);
                        *(f32x4*)(O + (size_t)row * 1024 + col) = h * alpha + g2 * acc[ai][bj][m][n]; } }
    }
};
struct InProjOrder {
    StaticOrder so; int G, c;
    __host__ __device__ void init(int G_, int c_) { so.init(16384, 3072, G_, c_); G = G_; c = c_; }
    __host__ __device__ bool next(int i, Unit& u) const {
        const long L = (long)i * G + c; if (L < 768) return so.next(i, u);
        const int e = (int)(L - 768); if (e >= 24) return false; u.pm = 64 + e / 3; u.pn = 8 + e % 3; return true; }
    __device__ __forceinline__ void a_ready(const Unit&) const {}
    __device__ __forceinline__ void done(const Unit&) const {}
};
template <class Epi, class Sched, bool ALIGN_EPI = false, bool SP2 = false>
__device__ __forceinline__ void gemm_phase(PG8_LAS unsigned char* lds, const Gemm g, const Sched& S, const Epi& E) {
    const int tid = threadIdx.x, wid = __builtin_amdgcn_readfirstlane(tid >> 6), lane = tid & 63, wr = wid >> 2, wc = wid & 3, fr = lane & 15, fq = lane >> 4;
    const int K = g.K, nt = K / BK;
    unsigned voffA[2], voffB[2];
#pragma unroll
    for (int i = 0; i < 2; ++i) { int R, C; stage_rc(tid * 16 + i * 8192, R, C); const int Rb = Epi::PERM ? ((R & ~31) + perm32(R & 31)) : R;
        voffA[i] = (unsigned)(R * K + C) * 2u; voffB[i] = (unsigned)(Rb * K + C) * 2u; }
    const size_t kstep = (size_t)(BK * 2);
    const size_t hstep = (size_t)HALF * K * 2;
    const size_t tstep = 2 * hstep;
    const unsigned ldsw = (unsigned)wid * 1024u;
    const int aoff = lds_byte(wr * 64 + fr, fq * 8), boff = lds_byte(wc * 32 + fr, fq * 8);
#define PG8_SA(b, h) (((b) * 2 + (h)) * HTB)
#define PG8_SB(b, h) ((4 + (b) * 2 + (h)) * HTB)
#define PG8_STAGE(bufoff, gbase, voff) do { _Pragma("unroll") for (int _i = 0; _i < 2; ++_i) \
        __builtin_amdgcn_global_load_lds((const unsigned*)((const char*)(gbase) + (voff)[_i]), (PG8_LAS unsigned*)(lds + (bufoff) + ldsw + _i * 8192), 16, 0, 0); } while (0)
#define PG8_LDA(dst, b, h) do { _Pragma("unroll") for (int m = 0; m < 4; ++m) _Pragma("unroll") for (int k = 0; k < 2; ++k) dst[m][k] = *(const PG8_LAS bf16x8*)(lds + PG8_SA(b, h) + aoff + m * 2048 + k * 1024); } while (0)
#define PG8_LDB(dst, b, h) do { _Pragma("unroll") for (int n = 0; n < 2; ++n) _Pragma("unroll") for (int k = 0; k < 2; ++k) dst[n][k] = *(const PG8_LAS bf16x8*)(lds + PG8_SB(b, h) + boff + n * 2048 + k * 1024); } while (0)
#define PG8_MMA(ai, bj, At, Bt) do { __builtin_amdgcn_s_setprio(1); _Pragma("unroll") for (int m = 0; m < 4; ++m) _Pragma("unroll") for (int n = 0; n < 2; ++n) _Pragma("unroll") for (int k = 0; k < 2; ++k) \
        acc[ai][bj][m][n] = __builtin_amdgcn_mfma_f32_16x16x32_bf16(Bt[n][k], At[m][k], acc[ai][bj][m][n], 0, 0, 0); __builtin_amdgcn_s_setprio(0); } while (0)
#define PG8_WAIT_V(n) asm volatile("s_waitcnt vmcnt(" #n ")" ::: "memory")
#define PG8_WAIT_L(n) asm volatile("s_waitcnt lgkmcnt(" #n ")" ::: "memory")
#define PG8_BAR __builtin_amdgcn_s_barrier()
#define PG8_SCHED __builtin_amdgcn_sched_barrier(0)
    Unit cur, nxt; int ui = 0;
    if (!S.next(0, cur)) return;
    f32x4 acc[2][2][4][2];
#pragma unroll
    for (int a = 0; a < 2; ++a)
#pragma unroll
        for (int b = 0; b < 2; ++b)
#pragma unroll
            for (int m = 0; m < 4; ++m)
#pragma unroll
                for (int n = 0; n < 2; ++n) acc[a][b][m][n] = (f32x4){0.f, 0.f, 0.f, 0.f};
    bf16x8 At[4][2], B0[2][2], B1[2][2];
    const char* cA = (const char*)g.A + (size_t)cur.pm * tstep; const char* cB = (const char*)g.Bt + (size_t)cur.pn * tstep;
    S.a_ready(cur);
    if constexpr (SP2) {
        PG8_STAGE(PG8_SB(0, 0), cB, voffB); PG8_STAGE(PG8_SB(0, 1), cB + hstep, voffB); PG8_STAGE(PG8_SA(0, 0), cA, voffA); PG8_STAGE(PG8_SA(0, 1), cA + hstep, voffA);
        if (wr == 1) PG8_BAR;
        PG8_WAIT_V(2); PG8_BAR;
        PG8_STAGE(PG8_SB(1, 0), cB + kstep, voffB); PG8_STAGE(PG8_SA(1, 0), cA + kstep, voffA); PG8_STAGE(PG8_SB(1, 1), cB + hstep + kstep, voffB);
        PG8_WAIT_V(6); PG8_BAR;
    } else {
        PG8_STAGE(PG8_SB(0, 0), cB, voffB); PG8_STAGE(PG8_SA(0, 0), cA, voffA); PG8_STAGE(PG8_SB(0, 1), cB + hstep, voffB); PG8_STAGE(PG8_SA(0, 1), cA + hstep, voffA);
        if (wr == 1) PG8_BAR;
        PG8_WAIT_V(4); PG8_BAR;
        PG8_STAGE(PG8_SB(1, 0), cB + kstep, voffB); PG8_STAGE(PG8_SA(1, 0), cA + kstep, voffA); PG8_STAGE(PG8_SB(1, 1), cB + hstep + kstep, voffB);
        PG8_WAIT_V(6); PG8_BAR;
    }
    for (;;) {
        const bool has_next = S.next(ui + 1, nxt);
        const char* nA = has_next ? (const char*)g.A + (size_t)nxt.pm * tstep : cA; const char* nB = has_next ? (const char*)g.Bt + (size_t)nxt.pn * tstep : cB;
        for (int t = 0; t < nt; t += 2) {
            const bool last = (t == nt - 2);
            const char* a1 = cA + (size_t)(t + 1) * kstep;
            const char* a2 = last ? nA : cA + (size_t)(t + 2) * kstep; const char* b2 = last ? nB : cB + (size_t)(t + 2) * kstep;
            const char* a3 = a2 + kstep; const char* b3 = b2 + kstep;
            if (last && has_next) S.a_ready(nxt);
            if constexpr (SP2) {
            PG8_LDB(B0, 0, 0); PG8_LDB(B1, 0, 1); PG8_SCHED; PG8_LDA(At, 0, 0); PG8_STAGE(PG8_SA(1, 1), a1 + hstep, voffA);
            PG8_WAIT_V(8); PG8_WAIT_L(0); PG8_BAR; PG8_MMA(0, 0, At, B0); PG8_MMA(0, 1, At, B1); PG8_BAR; PG8_SCHED;
            PG8_LDA(At, 0, 1); PG8_STAGE(PG8_SB(0, 0), b2, voffB); PG8_STAGE(PG8_SB(0, 1), b2 + hstep, voffB); PG8_STAGE(PG8_SA(0, 0), a2, voffA);
            PG8_WAIT_V(8); PG8_WAIT_L(0); PG8_BAR; PG8_MMA(1, 0, At, B0); PG8_MMA(1, 1, At, B1); PG8_BAR; PG8_SCHED;
            PG8_LDB(B0, 1, 0); PG8_LDB(B1, 1, 1); PG8_SCHED; PG8_LDA(At, 1, 0); PG8_STAGE(PG8_SA(0, 1), a2 + hstep, voffA);
            PG8_WAIT_V(8); PG8_WAIT_L(0); PG8_BAR; PG8_MMA(0, 0, At, B0); PG8_MMA(0, 1, At, B1); PG8_BAR; PG8_SCHED;
            PG8_LDA(At, 1, 1); PG8_STAGE(PG8_SB(1, 0), b3, voffB); PG8_STAGE(PG8_SB(1, 1), b3 + hstep, voffB); PG8_STAGE(PG8_SA(1, 0), a3, voffA);
            PG8_WAIT_V(8); PG8_WAIT_L(0); PG8_BAR; PG8_MMA(1, 0, At, B0); PG8_MMA(1, 1, At, B1); PG8_BAR; PG8_SCHED;
            } else {
            PG8_LDB(B0, 0, 0); PG8_SCHED; PG8_LDA(At, 0, 0); PG8_STAGE(PG8_SA(1, 1), a1 + hstep, voffA);
            PG8_WAIT_L(8); PG8_BAR; PG8_WAIT_L(0); PG8_MMA(0, 0, At, B0); PG8_BAR; PG8_SCHED;
            PG8_LDB(B1, 0, 1); PG8_STAGE(PG8_SB(0, 0), b2, voffB);
            PG8_BAR; PG8_WAIT_L(0); PG8_MMA(0, 1, At, B1); PG8_BAR;
            PG8_LDA(At, 0, 1); PG8_STAGE(PG8_SA(0, 0), a2, voffA);
            PG8_BAR; PG8_WAIT_L(0); PG8_MMA(1, 0, At, B0); PG8_BAR; PG8_SCHED;
            PG8_STAGE(PG8_SB(0, 1), b2 + hstep, voffB);
            PG8_WAIT_V(6); PG8_BAR; PG8_MMA(1, 1, At, B1); PG8_BAR;
            PG8_LDB(B0, 1, 0); PG8_SCHED; PG8_LDA(At, 1, 0); PG8_STAGE(PG8_SA(0, 1), a2 + hstep, voffA);
            PG8_WAIT_L(8); PG8_BAR; PG8_WAIT_L(0); PG8_MMA(0, 0, At, B0); PG8_BAR; PG8_SCHED;
            PG8_LDB(B1, 1, 1); PG8_STAGE(PG8_SB(1, 0), b3, voffB);
            PG8_BAR; PG8_WAIT_L(0); PG8_MMA(0, 1, At, B1); PG8_BAR;
            PG8_LDA(At, 1, 1); PG8_STAGE(PG8_SA(1, 0), a3, voffA);
            PG8_BAR; PG8_WAIT_L(0); PG8_MMA(1, 0, At, B0); PG8_BAR; PG8_SCHED;
            PG8_STAGE(PG8_SB(1, 1), b3 + hstep, voffB);
            PG8_WAIT_V(6); PG8_BAR; PG8_MMA(1, 1, At, B1); PG8_BAR;
            }
        }
        if constexpr (ALIGN_EPI) { if (wr == 0) PG8_BAR; }
        if constexpr (!Epi::AFTER_DRAIN) { E(acc, cur, wr, wc, fr, fq); S.done(cur); }
        if (!has_next) break;
#pragma unroll
        for (int a = 0; a < 2; ++a)
#pragma unroll
            for (int b = 0; b < 2; ++b)
#pragma unroll
                for (int m = 0; m < 4; ++m)
#pragma unroll
                    for (int n = 0; n < 2; ++n) acc[a][b][m][n] = (f32x4){0.f, 0.f, 0.f, 0.f};
        cur = nxt; cA = nA; cB = nB; ++ui;
        if constexpr (ALIGN_EPI) { if (wr == 1) PG8_BAR; }
    }
    PG8_WAIT_V(0);
    if constexpr (!ALIGN_EPI) { if (wr == 0) PG8_BAR; }
    PG8_BAR;
    if constexpr (Epi::AFTER_DRAIN) { E.fused(acc, cur, wr, wc, fr, fq, lds, wid, lane); S.done(cur); }
#undef PG8_SA
#undef PG8_SB
#undef PG8_STAGE
#undef PG8_LDA
#undef PG8_LDB
#undef PG8_MMA
#undef PG8_WAIT_V
#undef PG8_WAIT_L
#undef PG8_BAR
#undef PG8_SCHED
}
}

__device__ __forceinline__ void phase_conv(const Args& a, int bid, int nb) {
    const int tid = threadIdx.x, lane = tid & 63, wave = tid >> 6;
    const int gw = bid * NWAVES + wave, NGW = nb * NWAVES;
    const bf16* PROJ = (const bf16*)(a.ws + WS_PROJ);
    const bf16* U = (const bf16*)(a.ws + WS_U);
    const bf16* WDT = (const bf16*)(a.ws + WS_WDT_T);
    bf16* XB = (bf16*)(a.ws + WS_XBC);
    bf16* MG = (bf16*)(a.ws + WS_MERGED);
    float* DT = (float*)(a.ws + WS_DT);
    const float* scw = a.in[I_SCW]; const float* scb = a.in[I_SCB]; const float* cw = a.in[I_CONVW];
    for (int row = gw; row < MALL; row += NGW) {
        const bool lat = row < MLAT;
        const int pos = lat ? (row & 63) : ((row - MLAT) & 255), len = lat ? 64 : 256;
        const bool hasL = pos > 0, hasR = pos < len - 1;
        const bf16* P = PROJ + (size_t)row * NPROJ;
#pragma unroll
        for (int half = 0; half < 2; ++half) {
            const int ch0 = lane * 16 + half * 8;
            if (!lat && ch0 >= 768) continue;
            const v4u zc = {0u, 0u, 0u, 0u};
            const v4u cu = *(const v4u*)(P + XBC_OFF + ch0);
            const v4u le = hasL ? *(const v4u*)(P - NPROJ + XBC_OFF + ch0) : zc;
            const v4u ri = hasR ? *(const v4u*)(P + NPROJ + XBC_OFF + ch0) : zc;
            float o[8];
#pragma unroll
            for (int i = 0; i < 8; ++i) {
                const unsigned wc = i < 2 ? cu.x : i < 4 ? cu.y : i < 6 ? cu.z : cu.w;
                const unsigned wl = i < 2 ? le.x : i < 4 ? le.y : i < 6 ? le.z : le.w;
                const unsigned wr = i < 2 ? ri.x : i < 4 ? ri.y : i < 6 ? ri.z : ri.w;
                const float c = (i & 1) ? bfhi(wc) : bflo(wc), l = (i & 1) ? bfhi(wl) : bflo(wl), r = (i & 1) ? bfhi(wr) : bflo(wr);
                const int ch = ch0 + i;
                const float v = scw[ch] * l + scw[XBC + ch] * c + scw[2 * XBC + ch] * r + scb[ch];
                o[i] = silu_f(v);
            }
            v4u w; w.x = pk2(o[0], o[1]); w.y = pk2(o[2], o[3]); w.z = pk2(o[4], o[5]); w.w = pk2(o[6], o[7]);
            *(v4u*)(XB + (size_t)row * XBC + ch0) = w;
        }
        if (lat) {
            const int ch0 = lane * 8;
            const v4u zc = {0u, 0u, 0u, 0u};
            const v4u gb = *(const v4u*)(P + ch0);
            const v4u gc0 = *(const v4u*)(P + CONVW + ch0), gh0 = *(const v4u*)(P + 2 * CONVW + ch0);
            const v4u gcl = hasL ? *(const v4u*)(P - NPROJ + CONVW + ch0) : zc, ghl = hasL ? *(const v4u*)(P - NPROJ + 2 * CONVW + ch0) : zc;
            const v4u gcr = hasR ? *(const v4u*)(P + NPROJ + CONVW + ch0) : zc, ghr = hasR ? *(const v4u*)(P + NPROJ + 2 * CONVW + ch0) : zc;
            float o[8];
#pragma unroll
            for (int i = 0; i < 8; ++i) {
#define SEL(v) ((i & 1) ? bfhi(i < 2 ? v.x : i < 4 ? v.y : i < 6 ? v.z : v.w) : bflo(i < 2 ? v.x : i < 4 ? v.y : i < 6 ? v.z : v.w))
                const int ch = ch0 + i;
                const float pl = SEL(gcl) * SEL(ghl), pc = SEL(gc0) * SEL(gh0), pr = SEL(gcr) * SEL(ghr);
                o[i] = SEL(gb) * (cw[ch] * pl + cw[CONVW + ch] * pc + cw[2 * CONVW + ch] * pr);
#undef SEL
            }
            v4u w; w.x = pk2(o[0], o[1]); w.y = pk2(o[2], o[3]); w.z = pk2(o[4], o[5]); w.w = pk2(o[6], o[7]);
            *(v4u*)(MG + (size_t)row * D + ch0) = w;
        }
        {
            const v4u u0 = *(const v4u*)(U + (size_t)row * D + lane * 16), u1 = *(const v4u*)(U + (size_t)row * D + lane * 16 + 8);
            float uf[16];
            uf[0] = bflo(u0.x); uf[1] = bfhi(u0.x); uf[2] = bflo(u0.y); uf[3] = bfhi(u0.y); uf[4] = bflo(u0.z); uf[5] = bfhi(u0.z); uf[6] = bflo(u0.w); uf[7] = bfhi(u0.w);
            uf[8] = bflo(u1.x); uf[9] = bfhi(u1.x); uf[10] = bflo(u1.y); uf[11] = bfhi(u1.y); uf[12] = bflo(u1.z); uf[13] = bfhi(u1.z); uf[14] = bflo(u1.w); uf[15] = bfhi(u1.w);
            float mine = 0.f;
#pragma unroll
            for (int j = 0; j < 16; ++j) {
                const v4u w0 = *(const v4u*)(WDT + j * 1024 + lane * 16), w1 = *(const v4u*)(WDT + j * 1024 + lane * 16 + 8);
                float p = uf[0] * bflo(w0.x) + uf[1] * bfhi(w0.x) + uf[2] * bflo(w0.y) + uf[3] * bfhi(w0.y) + uf[4] * bflo(w0.z) + uf[5] * bfhi(w0.z) + uf[6] * bflo(w0.w) + uf[7] * bfhi(w0.w)
                        + uf[8] * bflo(w1.x) + uf[9] * bfhi(w1.x) + uf[10] * bflo(w1.y) + uf[11] * bfhi(w1.y) + uf[12] * bflo(w1.z) + uf[13] * bfhi(w1.z) + uf[14] * bflo(w1.w) + uf[15] * bfhi(w1.w);
                p = wave_sum(p);
                if (lane == j) mine = p;
            }
            if (lane < 16) DT[(size_t)row * 16 + lane] = softplus_f(mine + a.in[I_DTB][lane]);
        }
    }
}

__device__ __forceinline__ void phase_ssd_naive(const Args& a, unsigned char* lds, int bid, int nb) {
    const int tid = threadIdx.x, p = tid >> 3, nq = tid & 7;
    float* sx = (float*)lds;
    float* sB = sx + 64 * 64;
    float* sC = sB + 64 * 128;
    float* sdt = sC + 64 * 128;
    const bf16* XB = (const bf16*)(a.ws + WS_XBC);
    const float* DT = (const float*)(a.ws + WS_DT);
    bf16* YD = (bf16*)(a.ws + WS_YDIR);
    for (int item = bid; item < NBATCH * 2 * NH; item += nb) {
        const int b = item & 7, dir = (item >> 3) & 1, h = item >> 4, g = h >> 2;
        const float ah = -__expf(a.in[I_ALOG][dir * 8 + h]);
        float S[16];
#pragma unroll
        for (int i = 0; i < 16; ++i) S[i] = 0.f;
        for (int blk = 0; blk < 36; ++blk) {
            const bool isctx = blk < 4;
            int bi = isctx ? blk : blk - 4; const int nblk = isctx ? 4 : 32; if (dir) bi = nblk - 1 - bi;
            const int rowbase = isctx ? MLAT + b * CTXL + bi * 64 : b * SEQ + bi * 64;
            __syncthreads();
            { const int idx = tid * 8, t = idx >> 6, p0 = idx & 63;
              const v4u w = *(const v4u*)(XB + (size_t)(rowbase + t) * XBC + h * 64 + p0); float* d = sx + t * 64 + p0;
              d[0] = bflo(w.x); d[1] = bfhi(w.x); d[2] = bflo(w.y); d[3] = bfhi(w.y); d[4] = bflo(w.z); d[5] = bfhi(w.z); d[6] = bflo(w.w); d[7] = bfhi(w.w); }
#pragma unroll
            for (int it = 0; it < 2; ++it) { const int idx = tid * 8 + it * 4096, t = idx >> 7, n0 = idx & 127;
              { const v4u w = *(const v4u*)(XB + (size_t)(rowbase + t) * XBC + 512 + g * 128 + n0); float* d = sB + t * 128 + n0;
                d[0] = bflo(w.x); d[1] = bfhi(w.x); d[2] = bflo(w.y); d[3] = bfhi(w.y); d[4] = bflo(w.z); d[5] = bfhi(w.z); d[6] = bflo(w.w); d[7] = bfhi(w.w); }
              if (!isctx) { const v4u w = *(const v4u*)(XB + (size_t)(rowbase + t) * XBC + 768 + g * 128 + n0); float* d = sC + t * 128 + n0;
                d[0] = bflo(w.x); d[1] = bfhi(w.x); d[2] = bflo(w.y); d[3] = bfhi(w.y); d[4] = bflo(w.z); d[5] = bfhi(w.z); d[6] = bflo(w.w); d[7] = bfhi(w.w); } }
            if (tid < 64) sdt[tid] = DT[(size_t)(rowbase + tid) * 16 + dir * 8 + h];
            __syncthreads();
            for (int tt = 0; tt < 64; ++tt) {
                const int t = dir ? 63 - tt : tt;
                const float dtv = sdt[t], dA = __expf(dtv * ah), xv = sx[t * 64 + p] * dtv;
                float y = 0.f;
#pragma unroll
                for (int i = 0; i < 16; ++i) { S[i] = dA * S[i] + xv * sB[t * 128 + nq * 16 + i]; if (!isctx) y += S[i] * sC[t * 128 + nq * 16 + i]; }
                if (!isctx) {
                    y += __shfl_xor(y, 1); y += __shfl_xor(y, 2); y += __shfl_xor(y, 4);
                    if (nq == 0) YD[(size_t)dir * MLAT * SSDW + (size_t)(rowbase + t) * SSDW + h * 64 + p] = (bf16)f2bf(y);
                }
            }
        }
    }
}

__device__ __forceinline__ void phase_fin(const Args& a, int bid, int nb) {
    const int tid = threadIdx.x, lane = tid & 63, wave = tid >> 6;
    const int gw = bid * NWAVES + wave, NGW = nb * NWAVES;
    const bf16* PROJ = (const bf16*)(a.ws + WS_PROJ);
    const bf16* XB = (const bf16*)(a.ws + WS_XBC);
    const bf16* YD = (const bf16*)(a.ws + WS_YDIR);
    bf16* MG = (bf16*)(a.ws + WS_MERGED);
    for (int row = gw; row < MLAT; row += NGW) {
        const int ch0 = lane * 8;
        const v4u yf = *(const v4u*)(YD + (size_t)row * SSDW + ch0), yb = *(const v4u*)(YD + (size_t)MLAT * SSDW + (size_t)row * SSDW + ch0);
        const v4u xs = *(const v4u*)(XB + (size_t)row * XBC + ch0), zz = *(const v4u*)(PROJ + (size_t)row * NPROJ + Z_OFF + ch0);
        const float dd = a.in[I_SSDD][ch0 >> 6];
        float o[8]; float ss = 0.f;
#pragma unroll
        for (int i = 0; i < 8; ++i) {
#define SEL(v) ((i & 1) ? bfhi(i < 2 ? v.x : i < 4 ? v.y : i < 6 ? v.z : v.w) : bflo(i < 2 ? v.x : i < 4 ? v.y : i < 6 ? v.z : v.w))
            const float y = SEL(yf) + SEL(yb) + SEL(xs) * dd;
            const float yg = y * silu_f(SEL(zz));
#undef SEL
            o[i] = yg; ss += yg * yg;
        }
        const float r = rsqrtf(wave_sum(ss) * (1.f / SSDW) + RMS_EPS);
        const float* nw = a.in[I_SNW] + ch0;
        v4u w; w.x = pk2(o[0] * r * nw[0], o[1] * r * nw[1]); w.y = pk2(o[2] * r * nw[2], o[3] * r * nw[3]);
        w.z = pk2(o[4] * r * nw[4], o[5] * r * nw[5]); w.w = pk2(o[6] * r * nw[6], o[7] * r * nw[7]);
        *(v4u*)(MG + (size_t)row * D + SSDW + ch0) = w;
    }
}

__device__ __forceinline__ void phase_ln1(const Args& a, int bid, int nb) {
    const int tid = threadIdx.x, lane = tid & 63, wave = tid >> 6;
    const int gw = bid * NWAVES + wave, NGW = nb * NWAVES;
    const float* MOD = (const float*)(a.ws + WS_MOD);
    const float* V = (const float*)(a.ws + WS_V1PRE);
    bf16* H1 = (bf16*)(a.ws + WS_H1); bf16* U2 = (bf16*)(a.ws + WS_U2);
    for (int row = gw; row < MLAT; row += NGW) {
        const int r = row / SEQ;
        const f32x4* xr = (const f32x4*)(V + (size_t)row * D) + lane;
        f32x4 v[4]; float s = 0.f;
#pragma unroll
        for (int j = 0; j < 4; ++j) { v[j] = xr[64 * j]; s += (v[j].x + v[j].y) + (v[j].z + v[j].w); }
        const float mean = wave_sum(s) * (1.f / D); float s2 = 0.f;
#pragma unroll
        for (int j = 0; j < 4; ++j) { v[j] = v[j] - mean; s2 += (v[j].x * v[j].x + v[j].y * v[j].y) + (v[j].z * v[j].z + v[j].w * v[j].w); }
        const float rstd = 1.f / sqrtf(wave_sum(s2) * (1.f / D) + LN_EPS);
        v2u* oh = (v2u*)(H1 + (size_t)row * D) + lane; v2u* ou = (v2u*)(U2 + (size_t)row * D) + lane;
#pragma unroll
        for (int j = 0; j < 4; ++j) {
            const int c = 4 * (lane + 64 * j);
            const f32x4 g = *(const f32x4*)(a.in[I_LN1G] + c), bb = *(const f32x4*)(a.in[I_LN1B] + c);
            const f32x4 sh = *(const f32x4*)(MOD + r * 6144 + 3072 + c), sc = *(const f32x4*)(MOD + r * 6144 + 4096 + c);
            const f32x4 h = v[j] * rstd * g + bb;
            const f32x4 u = h * (1.f + sc) + sh;
            v2u w; w.x = pk2(h.x, h.y); w.y = pk2(h.z, h.w); oh[64 * j] = w;
            v2u w2; w2.x = pk2(u.x, u.y); w2.y = pk2(u.z, u.w); ou[64 * j] = w2;
        }
    }
}
__device__ __forceinline__ void phase_ln2(const Args& a, int bid, int nb) {
    const int tid = threadIdx.x, lane = tid & 63, wave = tid >> 6;
    const int gw = bid * NWAVES + wave, NGW = nb * NWAVES;
    for (int row = gw; row < MLAT; row += NGW) {
        f32x4* xr = (f32x4*)(a.out + (size_t)row * D) + lane;
        f32x4 v[4]; float s = 0.f;
#pragma unroll
        for (int j = 0; j < 4; ++j) { v[j] = xr[64 * j]; s += (v[j].x + v[j].y) + (v[j].z + v[j].w); }
        const float mean = wave_sum(s) * (1.f / D); float s2 = 0.f;
#pragma unroll
        for (int j = 0; j < 4; ++j) { v[j] = v[j] - mean; s2 += (v[j].x * v[j].x + v[j].y * v[j].y) + (v[j].z * v[j].z + v[j].w * v[j].w); }
        const float rstd = 1.f / sqrtf(wave_sum(s2) * (1.f / D) + LN_EPS);
#pragma unroll
        for (int j = 0; j < 4; ++j) {
            const int c = 4 * (lane + 64 * j);
            const f32x4 g = *(const f32x4*)(a.in[I_LN2G] + c), bb = *(const f32x4*)(a.in[I_LN2B] + c);
            xr[64 * j] = v[j] * rstd * g + bb;
        }
    }
}

__global__ void __launch_bounds__(NT, 2) mk_fwd(Args a) {
    extern __shared__ __attribute__((aligned(16))) unsigned char lds[];
    const int bid = blockIdx.x, nb = gridDim.x;
    const int lo = a.ph_lo, hi = a.ph_hi;
    unsigned char* ws = a.ws;
#define IN(k) (lo <= (k) && (k) < hi)
#define SEAM(k) do { if (IN(k) && IN((k) + 1)) { cg::this_grid().sync(); } } while (0)
    if (IN(0)) phase_p0a(a, lds, bid, nb);
    SEAM(0);
    if (IN(1)) phase_p0b(a, bid, nb);
    SEAM(1);
    if (IN(2)) {
        pg8::Gemm g{(const bf16*)(ws + WS_U), (const bf16*)(ws + WS_WIN_T), MALL, NPROJ, D}; pg8::InProjOrder S; S.init(nb, bid);
        pg8::EpiBf16<0> E{(bf16*)(ws + WS_PROJ), NPROJ};
        pg8::gemm_phase<pg8::EpiBf16<0>, pg8::InProjOrder, true, true>((LAS unsigned char*)lds, g, S, E);
    }
    SEAM(2);
    if (IN(3)) phase_conv(a, bid, nb);
    SEAM(3);
    if (IN(4)) phase_ssd_naive(a, lds, bid, nb);
    SEAM(4);
    if (IN(5)) phase_fin(a, bid, nb);
    SEAM(5);
    if (IN(6)) {
        pg8::Gemm g{(const bf16*)(ws + WS_MERGED), (const bf16*)(ws + WS_WOUT_T), MLAT, D, D}; pg8::StaticOrder S; S.init(MLAT, D, nb, bid);
        pg8::EpiRes1 E{a.in[I_X], (const float*)(ws + WS_STATS), a.in[I_LNG], a.in[I_LNB], (const float*)(ws + WS_MOD) + 2048, (float*)(ws + WS_V1PRE), ALPHA};
        pg8::gemm_phase<pg8::EpiRes1, pg8::StaticOrder, true, true>((LAS unsigned char*)lds, g, S, E);
    }
    SEAM(6);
    if (IN(7)) phase_ln1(a, bid, nb);
    SEAM(7);
    if (IN(8)) {
        pg8::Gemm g{(const bf16*)(ws + WS_U2), (const bf16*)(ws + WS_WFF1_T), MLAT, FF, D}; pg8::StaticOrder S; S.init(MLAT, FF, nb, bid);
        pg8::EpiBf16<1> E{(bf16*)(ws + WS_ACT), FF};
        pg8::gemm_phase<pg8::EpiBf16<1>, pg8::StaticOrder, true, true>((LAS unsigned char*)lds, g, S, E);
    }
    SEAM(8);
    if (IN(9)) {
        pg8::Gemm g{(const bf16*)(ws + WS_ACT), (const bf16*)(ws + WS_WFF2_T), MLAT, D, FF}; pg8::StaticOrder S; S.init(MLAT, D, nb, bid);
        pg8::EpiRes2 E{(const bf16*)(ws + WS_H1), (const float*)(ws + WS_MOD) + 5120, a.out, ALPHA};
        pg8::gemm_phase<pg8::EpiRes2, pg8::StaticOrder, true, true>((LAS unsigned char*)lds, g, S, E);
    }
    SEAM(9);
    if (IN(10)) phase_ln2(a, bid, nb);
#undef IN
#undef SEAM
}

extern "C" void kernel_launch(void* const* d_in, const int* in_sizes, int n_in, void* d_out, int out_size, void* d_ws, size_t ws_size, hipStream_t stream) {
    static int grid = 0;
    if (grid == 0) {
        if (n_in != 23 || out_size != MLAT * D || ws_size < WS_END) { fprintf(stderr, "kernel_launch: unexpected shapes n_in %d out %d ws %zu\n", n_in, out_size, ws_size); grid = -1; return; }
        int dev = 0, cus = 0, per_cu = 0;
        (void)hipGetDevice(&dev);
        (void)hipDeviceGetAttribute(&cus, hipDeviceAttributeMultiprocessorCount, dev);
        (void)hipFuncSetAttribute((const void*)mk_fwd, hipFuncAttributeMaxDynamicSharedMemorySize, LDS_BYTES);
        (void)hipOccupancyMaxActiveBlocksPerMultiprocessor(&per_cu, (const void*)mk_fwd, NT, LDS_BYTES);
        (void)hipGetLastError();
        if (per_cu < 1) { fprintf(stderr, "kernel_launch: occupancy query says %d blocks/CU\n", per_cu); per_cu = 1; }
        grid = cus;
    }
    if (grid < 0) return;
    Args a{};
    for (int i = 0; i < 23; ++i) a.in[i] = (const float*)d_in[i];
    a.out = (float*)d_out; a.ws = (unsigned char*)d_ws;
#if ONE_LAUNCH
    a.ph_lo = 0; a.ph_hi = NPHASES;
    void* args[] = {&a};
    hipError_t e = hipLaunchCooperativeKernel((const void*)mk_fwd, dim3(grid), dim3(NT), args, LDS_BYTES, stream);
    if (e != hipSuccess) fprintf(stderr, "cooperative launch failed: %s (grid %d)\n", hipGetErrorString(e), grid);
#else
    for (int ph = 0; ph < NPHASES; ++ph) {
        a.ph_lo = ph; a.ph_hi = ph + 1;
        hipLaunchKernelGGL(mk_fwd, dim3(grid), dim3(NT), LDS_BYTES, stream, a);
    }
#endif
}
```

```cpp
#include <hip/hip_runtime.h>
#include <hip/hip_cooperative_groups.h>
#include <cstdio>
#include <cstdint>
namespace cg = cooperative_groups;

#ifndef ONE_LAUNCH
#define ONE_LAUNCH 1
#endif

constexpr int D = 1024, NBATCH = 8, SEQ = 2048, CTXL = 256;
constexpr int MLAT = NBATCH * SEQ, MCTX = NBATCH * CTXL, MALL = MLAT + MCTX;
constexpr int IN_DIM = 3088, NPROJ = 3072, FF = 4096;
constexpr int CONVW = 512, SSDW = 512, XBC = 1024, NH = 8, HD = 64, NS = 128;
constexpr int Z_OFF = 1536, XBC_OFF = 2048;
constexpr float LN_EPS = 1e-5f, RMS_EPS = 1e-5f, ALPHA = 1.189207115002721f;
constexpr int NT = 512, NWAVES = 8, NPHASES = 11;

constexpr size_t MiB = 1u << 20;
constexpr size_t WS_MOD = 0, WS_STATS = 256 * 1024;
constexpr size_t WS_WIN_T = 1 * MiB, WS_WDT_T = 7 * MiB, WS_WOUT_T = 8 * MiB, WS_WFF1_T = 10 * MiB, WS_WFF2_T = 18 * MiB;
constexpr size_t WS_U = 26 * MiB, WS_YDIR = 26 * MiB, WS_U2 = 26 * MiB;
constexpr size_t WS_PROJ = 62 * MiB, WS_V1PRE = 62 * MiB, WS_ACT = 62 * MiB;
constexpr size_t WS_XBC = 170 * MiB, WS_DT = 206 * MiB, WS_MERGED = 208 * MiB, WS_H1 = 208 * MiB;
constexpr size_t WS_END = 240 * MiB;
constexpr int LDS_BYTES = 147456;

typedef unsigned short bf16;
#define LAS __attribute__((address_space(3)))
typedef unsigned v4u __attribute__((ext_vector_type(4)));
typedef unsigned v2u __attribute__((ext_vector_type(2)));
typedef float f32x4 __attribute__((ext_vector_type(4)));

__device__ __forceinline__ float bf2f(unsigned v) { return __uint_as_float(v << 16); }
__device__ __forceinline__ float bflo(unsigned w) { return __uint_as_float(w << 16); }
__device__ __forceinline__ float bfhi(unsigned w) { return __uint_as_float(w & 0xffff0000u); }
__device__ __forceinline__ unsigned f2bf(float f) { unsigned u = __float_as_uint(f); return (u + 0x7fffu + ((u >> 16) & 1u)) >> 16; }
__device__ __forceinline__ unsigned pk2(float lo, float hi) { return f2bf(lo) | (f2bf(hi) << 16); }
__device__ __forceinline__ float wave_sum(float v) {
#pragma unroll
    for (int o = 1; o < 64; o <<= 1) v += __shfl_xor(v, o);
    return v;
}
__device__ __forceinline__ float silu_f(float v) { return v / (1.f + __expf(-v)); }
__device__ __forceinline__ float softplus_f(float v) { return v > 20.f ? v : log1pf(__expf(v)); }

struct Args { const float* in[23]; float* out; unsigned char* ws; int ph_lo, ph_hi; };
enum { I_X = 0, I_C, I_CTX, I_CCTX, I_LNG, I_LNB, I_WMOD, I_BMOD, I_WIN, I_CONVW, I_SCW, I_SCB, I_DTB, I_ALOG, I_SSDD, I_SNW, I_WOUT,
       I_LN1G, I_LN1B, I_WFF1, I_WFF2, I_LN2G, I_LN2B };

__device__ __forceinline__ void transpose_item(const float* W, int ldw, int K, int N, bf16* WT, float* scr, int item, int lane) {
    const int nblk = N / 32, kb = item / nblk, nb = item % nblk, k0 = 64 * kb, n0 = 32 * nb;
#pragma unroll 8
    for (int i = 0; i < 32; ++i) { const int kk = 2 * i + (lane >> 5); scr[kk * 33 + (lane & 31)] = W[(size_t)(k0 + kk) * ldw + n0 + (lane & 31)]; }
    __builtin_amdgcn_s_waitcnt(0); __builtin_amdgcn_wave_barrier();
    const int c = lane & 7;
#pragma unroll
    for (int j = 0; j < 4; ++j) { const int n = (lane >> 3) + 8 * j; const float* s = scr + (8 * c) * 33 + n;
        v4u o; o.x = pk2(s[0 * 33], s[1 * 33]); o.y = pk2(s[2 * 33], s[3 * 33]); o.z = pk2(s[4 * 33], s[5 * 33]); o.w = pk2(s[6 * 33], s[7 * 33]);
        *(v4u*)(WT + (size_t)(n0 + n) * K + k0 + 8 * c) = o; }
    __builtin_amdgcn_s_waitcnt(0); __builtin_amdgcn_wave_barrier();
}

__device__ __forceinline__ void phase_p0a(const Args& a, unsigned char* lds, int bid, int nb) {
    const int tid = threadIdx.x, lane = tid & 63, wave = tid >> 6;
    unsigned char* ws = a.ws;
    if (bid < 96) {
        float* sC = (float*)lds;
        float* part = (float*)(lds + 40960);
        for (int i = tid; i < 9 * 1024; i += NT) { const int r = i >> 10, k = i & 1023; const float v = r < 8 ? a.in[I_C][r * 1024 + k] : a.in[I_CCTX][k]; sC[i] = silu_f(v); }
        __syncthreads();
        float* MOD = (float*)(ws + WS_MOD);
        for (int item = bid; item < 96; item += nb) {
            const int j = item * 64 + lane, k0 = wave * 128;
            float acc[9];
#pragma unroll
            for (int r = 0; r < 9; ++r) acc[r] = 0.f;
            const float* wm = a.in[I_WMOD];
#pragma unroll 4
            for (int k = k0; k < k0 + 128; ++k) { const float w = wm[(size_t)k * 6144 + j];
#pragma unroll
                for (int r = 0; r < 9; ++r) acc[r] += sC[r * 1024 + k] * w; }
#pragma unroll
            for (int r = 0; r < 9; ++r) part[(wave * 9 + r) * 64 + lane] = acc[r];
            __syncthreads();
            for (int idx = tid; idx < 576; idx += NT) { const int r = idx >> 6, l = idx & 63; float s = a.in[I_BMOD][item * 64 + l];
#pragma unroll
                for (int w = 0; w < 8; ++w) s += part[(w * 9 + r) * 64 + l];
                MOD[r * 6144 + item * 64 + l] = s; }
            __syncthreads();
        }
    }
    __syncthreads();
    { bf16* WDT = (bf16*)(ws + WS_WDT_T);
      for (int i = bid * NT + tid; i < 16 * 1024; i += nb * NT) { const int j = i >> 10, k = i & 1023; WDT[i] = (bf16)f2bf(a.in[I_WIN][(size_t)k * IN_DIM + NPROJ + j]); } }
    float* scr = (float*)(lds + wave * 16384);
    const int gw = bid * NWAVES + wave, NGW = nb * NWAVES;
    constexpr int IT_IN = 16 * 96, IT_OUT = 16 * 32, IT_F1 = 16 * 128, IT_F2 = 64 * 32, IT_ALL = IT_IN + IT_OUT + IT_F1 + IT_F2;
    for (int it = gw; it < IT_ALL; it += NGW) {
        int r = it;
        if (r < IT_IN) { transpose_item(a.in[I_WIN], IN_DIM, D, NPROJ, (bf16*)(ws + WS_WIN_T), scr, r, lane); continue; } r -= IT_IN;
        if (r < IT_OUT) { transpose_item(a.in[I_WOUT], D, D, D, (bf16*)(ws + WS_WOUT_T), scr, r, lane); continue; } r -= IT_OUT;
        if (r < IT_F1) { transpose_item(a.in[I_WFF1], FF, D, FF, (bf16*)(ws + WS_WFF1_T), scr, r, lane); continue; } r -= IT_F1;
        transpose_item(a.in[I_WFF2], D, FF, D, (bf16*)(ws + WS_WFF2_T), scr, r, lane);
    }
}

__device__ __forceinline__ void phase_p0b(const Args& a, int bid, int nb) {
    const int tid = threadIdx.x, lane = tid & 63, wave = tid >> 6;
    const int gw = bid * NWAVES + wave, NGW = nb * NWAVES;
    const float* MOD = (const float*)(a.ws + WS_MOD);
    float* STATS = (float*)(a.ws + WS_STATS);
    bf16* U = (bf16*)(a.ws + WS_U);
    for (int row = gw; row < MALL; row += NGW) {
        const float* src = row < MLAT ? a.in[I_X] + (size_t)row * D : a.in[I_CTX] + (size_t)(row - MLAT) * D;
        const int r = row < MLAT ? row / SEQ : 8;
        const f32x4* xr = (const f32x4*)src + lane;
        f32x4 v[4]; float s = 0.f;
#pragma unroll
        for (int j = 0; j < 4; ++j) { v[j] = xr[64 * j]; s += (v[j].x + v[j].y) + (v[j].z + v[j].w); }
        const float mean = wave_sum(s) * (1.f / D); float s2 = 0.f;
#pragma unroll
        for (int j = 0; j < 4; ++j) { v[j] = v[j] - mean; s2 += (v[j].x * v[j].x + v[j].y * v[j].y) + (v[j].z * v[j].z + v[j].w * v[j].w); }
        const float rstd = 1.f / sqrtf(wave_sum(s2) * (1.f / D) + LN_EPS);
        if (lane == 0) { STATS[2 * row] = mean; STATS[2 * row + 1] = rstd; }
        v2u* o8 = (v2u*)(U + (size_t)row * D) + lane;
#pragma unroll
        for (int j = 0; j < 4; ++j) {
            const int c = 4 * (lane + 64 * j);
            const f32x4 g = *(const f32x4*)(a.in[I_LNG] + c), bb = *(const f32x4*)(a.in[I_LNB] + c);
            const f32x4 sh = *(const f32x4*)(MOD + r * 6144 + c), sc = *(const f32x4*)(MOD + r * 6144 + 1024 + c);
            const f32x4 h = v[j] * rstd * g + bb;
            const f32x4 u = h * (1.f + sc) + sh;
            v2u w; w.x = pk2(u.x, u.y); w.y = pk2(u.z, u.w); o8[64 * j] = w;
        }
    }
}

template <class Epi, class Ok>
__device__ __forceinline__ void gemm_naive(unsigned char* lds, const bf16* A, const bf16* Bt, int M, int N, int K, int bid, int nb, const Epi& epi, const Ok& ok) {
    float* As = (float*)lds; float* Bs = As + 64 * 33;
    const int tid = threadIdx.x, row = tid >> 3, cgp = tid & 7;
    const int tilesN = N / 64, ntiles = (M / 64) * tilesN;
    for (int tile = bid; tile < ntiles; tile += nb) {
        const int tm = tile / tilesN, tn = tile % tilesN;
        if (!ok(tm, tn)) continue;
        float acc[8];
#pragma unroll
        for (int j = 0; j < 8; ++j) acc[j] = 0.f;
        for (int k0 = 0; k0 < K; k0 += 32) {
            const int r = tid >> 3, c4 = (tid & 7) * 4;
            const v2u av = *(const v2u*)(A + (size_t)(tm * 64 + r) * K + k0 + c4);
            const v2u bv = *(const v2u*)(Bt + (size_t)(tn * 64 + r) * K + k0 + c4);
            __syncthreads();
            As[r * 33 + c4 + 0] = bflo(av.x); As[r * 33 + c4 + 1] = bfhi(av.x); As[r * 33 + c4 + 2] = bflo(av.y); As[r * 33 + c4 + 3] = bfhi(av.y);
            Bs[r * 33 + c4 + 0] = bflo(bv.x); Bs[r * 33 + c4 + 1] = bfhi(bv.x); Bs[r * 33 + c4 + 2] = bflo(bv.y); Bs[r * 33 + c4 + 3] = bfhi(bv.y);
            __syncthreads();
#pragma unroll 8
            for (int k = 0; k < 32; ++k) { const float av1 = As[row * 33 + k];
#pragma unroll
                for (int j = 0; j < 8; ++j) acc[j] += av1 * Bs[(cgp * 8 + j) * 33 + k]; }
        }
#pragma unroll
        for (int j = 0; j < 8; ++j) epi(tm * 64 + row, tn * 64 + cgp * 8 + j, acc[j]);
    }
}

namespace pg8 {
#define PG8_LAS __attribute__((address_space(3)))
typedef unsigned short bf16_t;
typedef short bf16x8 __attribute__((ext_vector_type(8)));
typedef float f32x4 __attribute__((ext_vector_type(4)));
typedef unsigned u32x4 __attribute__((ext_vector_type(4)));
constexpr int BM = 256, BK = 64, HALF = 128, HTB = HALF * BK * 2  , STAGE_BYTES = 8 * HTB, NXCD = 8, WGM = 8;

__host__ __device__ __forceinline__ int lds_byte(int r, int c) { const int st = (r >> 4) * 2 + (c >> 5), rr = r & 15, cc = c & 31, ob = rr * 64 + cc * 2; return st * 1024 + (ob ^ (((ob >> 9) & 1) << 5)); }
__host__ __device__ __forceinline__ void stage_rc(int b, int& R, int& C) { const int st = b / 1024, sb = b % 1024, swz = sb ^ (((sb >> 9) & 1) << 5); R = (st >> 1) * 16 + swz / 64; C = (st & 1) * 32 + (swz % 64) / 2; }
__host__ __device__ __forceinline__ int perm32(int rho) { const int n = rho >> 4, i = rho & 15; return 8 * (i >> 2) + 4 * n + (i & 3); }

struct Unit { int pm, pn; };
struct Gemm { const bf16_t* A; const bf16_t* Bt; int M, N, K; };

struct StaticOrder {
    int nM, nN, nwg, G, c;
    __host__ __device__ void init(int M, int N, int G_, int c_) { nM = M / BM; nN = N / BM; nwg = nM * nN; G = G_; c = c_; }
    __host__ __device__ bool next(int i, Unit& u) const {
        const long L = (long)i * G + c; if (L >= nwg) return false;
        int wgid = (int)L; { const int q = nwg / NXCD, r = nwg % NXCD, xcd = wgid % NXCD, off = wgid / NXCD; wgid = (xcd < r ? xcd * (q + 1) : r * (q + 1) + (xcd - r) * q) + off; }
        const int nig = WGM * nN, gid = wgid / nig, fm = gid * WGM, gsz = (nM - fm) < WGM ? (nM - fm) : WGM;
        u.pm = fm + ((wgid % nig) % gsz); u.pn = (wgid % nig) / gsz; return true;
    }
    __device__ __forceinline__ void a_ready(const Unit&) const {}
    __device__ __forceinline__ void done(const Unit&) const {}
};


__device__ __forceinline__ unsigned cvt_pk_bf16(float lo, float hi) { unsigned r; asm volatile("v_cvt_pk_bf16_f32 %0, %1, %2" : "=v"(r) : "v"(lo), "v"(hi)); return r; }
template <int ACT  > struct EpiBf16 {
    static constexpr bool PERM = true, AFTER_DRAIN = false;
    bf16_t* O; int ldc;
    __device__ __forceinline__ void operator()(const f32x4 (&acc)[2][2][4][2], const Unit& u, int wr, int wc, int fr, int fq) const {
        const int row0 = u.pm * BM + wr * 64 + fr; const int col0 = u.pn * BM + wc * 32 + 8 * fq;
#pragma unroll
        for (int ai = 0; ai < 2; ++ai)
#pragma unroll
            for (int m = 0; m < 4; ++m) { bf16_t* rowp = O + (size_t)(row0 + ai * HALF + m * 16) * ldc + col0;
#pragma unroll
                for (int bj = 0; bj < 2; ++bj) { f32x4 v0 = acc[ai][bj][m][0], v1 = acc[ai][bj][m][1];
                    if (ACT == 1) {
#pragma unroll
                        for (int e = 0; e < 4; ++e) { const float a0 = v0[e] > 0.f ? v0[e] : 0.f, a1 = v1[e] > 0.f ? v1[e] : 0.f; v0[e] = a0 * a0; v1[e] = a1 * a1; } }
                    u32x4 w; w.x = cvt_pk_bf16(v0[0], v0[1]); w.y = cvt_pk_bf16(v0[2], v0[3]); w.z = cvt_pk_bf16(v1[0], v1[1]); w.w = cvt_pk_bf16(v1[2], v1[3]);
                    *(u32x4*)(rowp + bj * HALF) = w; } }
    }
};
struct EpiRes1 {
    static constexpr bool PERM = false, AFTER_DRAIN = false;
    const float* x; const float* stats; const float* lng; const float* lnb; const float* modg; float* V; float alpha;
    __device__ __forceinline__ void operator()(const f32x4 (&acc)[2][2][4][2], const Unit& u, int wr, int wc, int fr, int fq) const {
        const int b = u.pm >> 3; const int colb = u.pn * BM + wc * 32 + 4 * fq;
#pragma unroll
        for (int bj = 0; bj < 2; ++bj)
#pragma unroll
            for (int n = 0; n < 2; ++n) { const int col = colb + bj * HALF + n * 16;
                const f32x4 g = *(const f32x4*)(lng + col), bb = *(const f32x4*)(lnb + col), g1 = *(const f32x4*)(modg + b * 6144 + col);
#pragma unroll
                for (int ai = 0; ai < 2; ++ai)
#pragma unroll
                    for (int m = 0; m < 4; ++m) { const int row = u.pm * BM + ai * HALF + wr * 64 + m * 16 + fr;
                        const float mean = stats[2 * row], rstd = stats[2 * row + 1];
                        const f32x4 xv = *(const f32x4*)(x + (size_t)row * 1024 + col);
                        const f32x4 h = (xv - mean) * rstd * g + bb;
                        *(f32x4*)(V + (size_t)row * 1024 + col) = h * alpha + g1 * acc[ai][bj][m][n]; } }
    }
};
struct EpiRes2 {
    static constexpr bool PERM = false, AFTER_DRAIN = false;
    const bf16_t* H1; const float* modg; float* O; float alpha;
    __device__ __forceinline__ void operator()(const f32x4 (&acc)[2][2][4][2], const Unit& u, int wr, int wc, int fr, int fq) const {
        typedef unsigned u32x2 __attribute__((ext_vector_type(2)));
        const int b = u.pm >> 3; const int colb = u.pn * BM + wc * 32 + 4 * fq;
#pragma unroll
        for (int bj = 0; bj < 2; ++bj)
#pragma unroll
            for (int n = 0; n < 2; ++n) { const int col = colb + bj * HALF + n * 16;
                const f32x4 g2 = *(const f32x4*)(modg + b * 6144 + col);
#pragma unroll
                for (int ai = 0; ai < 2; ++ai)
#pragma unroll
                    for (int m = 0; m < 4; ++m) { const int row = u.pm * BM + ai * HALF + wr * 64 + m * 16 + fr;
                        const u32x2 hw = *(const u32x2*)(H1 + (size_t)row * 1024 + col);
                        f32x4 h; h[0] = __uint_as_float(hw.x << 16); h[1] = __uint_as_float(hw.x & 0xffff0000u); h[2] = __uint_as_float(hw.y << 16); h[3] = __uint_as_float(hw.y & 0xffff0000u);
                        *(f32x4*)(O + (size_t)row * 1024 + col) = h * alpha + g2 * acc[ai][bj][m][n]; } }
    }
};
struct InProjOrder {
    StaticOrder so; int G, c;
    __host__ __device__ void init(int G_, int c_) { so.init(16384, 3072, G_, c_); G = G_; c = c_; }
    __host__ __device__ bool next(int i, Unit& u) const {
        const long L = (long)i * G + c; if (L < 768) return so.next(i, u);
        const int e = (int)(L - 768); if (e >= 24) return false; u.pm = 64 + e / 3; u.pn = 8 + e % 3; return true; }
    __device__ __forceinline__ void a_ready(const Unit&) const {}
    __device__ __forceinline__ void done(const Unit&) const {}
};
template <class Epi, class Sched, bool ALIGN_EPI = false, bool SP2 = false>
__device__ __forceinline__ void gemm_phase(PG8_LAS unsigned char* lds, const Gemm g, const Sched& S, const Epi& E) {
    const int tid = threadIdx.x, wid = __builtin_amdgcn_readfirstlane(tid >> 6), lane = tid & 63, wr = wid >> 2, wc = wid & 3, fr = lane & 15, fq = lane >> 4;
    const int K = g.K, nt = K / BK;
    unsigned voffA[2], voffB[2];
#pragma unroll
    for (int i = 0; i < 2; ++i) { int R, C; stage_rc(tid * 16 + i * 8192, R, C); const int Rb = Epi::PERM ? ((R & ~31) + perm32(R & 31)) : R;
        voffA[i] = (unsigned)(R * K + C) * 2u; voffB[i] = (unsigned)(Rb * K + C) * 2u; }
    const size_t kstep = (size_t)(BK * 2);
    const size_t hstep = (size_t)HALF * K * 2;
    const size_t tstep = 2 * hstep;
    const unsigned ldsw = (unsigned)wid * 1024u;
    const int aoff = lds_byte(wr * 64 + fr, fq * 8), boff = lds_byte(wc * 32 + fr, fq * 8);
#define PG8_SA(b, h) (((b) * 2 + (h)) * HTB)
#define PG8_SB(b, h) ((4 + (b) * 2 + (h)) * HTB)
#define PG8_STAGE(bufoff, gbase, voff) do { _Pragma("unroll") for (int _i = 0; _i < 2; ++_i) \
        __builtin_amdgcn_global_load_lds((const unsigned*)((const char*)(gbase) + (voff)[_i]), (PG8_LAS unsigned*)(lds + (bufoff) + ldsw + _i * 8192), 16, 0, 0); } while (0)
#define PG8_LDA(dst, b, h) do { _Pragma("unroll") for (int m = 0; m < 4; ++m) _Pragma("unroll") for (int k = 0; k < 2; ++k) dst[m][k] = *(const PG8_LAS bf16x8*)(lds + PG8_SA(b, h) + aoff + m * 2048 + k * 1024); } while (0)
#define PG8_LDB(dst, b, h) do { _Pragma("unroll") for (int n = 0; n < 2; ++n) _Pragma("unroll") for (int k = 0; k < 2; ++k) dst[n][k] = *(const PG8_LAS bf16x8*)(lds + PG8_SB(b, h) + boff + n * 2048 + k * 1024); } while (0)
#define PG8_MMA(ai, bj, At, Bt) do { __builtin_amdgcn_s_setprio(1); _Pragma("unroll") for (int m = 0; m < 4; ++m) _Pragma("unroll") for (int n = 0; n < 2; ++n) _Pragma("unroll") for (int k = 0; k < 2; ++k) \
        acc[ai][bj][m][n] = __builtin_amdgcn_mfma_f32_16x16x32_bf16(Bt[n][k], At[m][k], acc[ai][bj][m][n], 0, 0, 0); __builtin_amdgcn_s_setprio(0); } while (0)
#define PG8_WAIT_V(n) asm volatile("s_waitcnt vmcnt(" #n ")" ::: "memory")
#define PG8_WAIT_L(n) asm volatile("s_waitcnt lgkmcnt(" #n ")" ::: "memory")
#define PG8_BAR __builtin_amdgcn_s_barrier()
#define PG8_SCHED __builtin_amdgcn_sched_barrier(0)
    Unit cur, nxt; int ui = 0;
    if (!S.next(0, cur)) return;
    f32x4 acc[2][2][4][2];
#pragma unroll
    for (int a = 0; a < 2; ++a)
#pragma unroll
        for (int b = 0; b < 2; ++b)
#pragma unroll
            for (int m = 0; m < 4; ++m)
#pragma unroll
                for (int n = 0; n < 2; ++n) acc[a][b][m][n] = (f32x4){0.f, 0.f, 0.f, 0.f};
    bf16x8 At[4][2], B0[2][2], B1[2][2];
    const char* cA = (const char*)g.A + (size_t)cur.pm * tstep; const char* cB = (const char*)g.Bt + (size_t)cur.pn * tstep;
    S.a_ready(cur);
    if constexpr (SP2) {
        PG8_STAGE(PG8_SB(0, 0), cB, voffB); PG8_STAGE(PG8_SB(0, 1), cB + hstep, voffB); PG8_STAGE(PG8_SA(0, 0), cA, voffA); PG8_STAGE(PG8_SA(0, 1), cA + hstep, voffA);
        if (wr == 1) PG8_BAR;
        PG8_WAIT_V(2); PG8_BAR;
        PG8_STAGE(PG8_SB(1, 0), cB + kstep, voffB); PG8_STAGE(PG8_SA(1, 0), cA + kstep, voffA); PG8_STAGE(PG8_SB(1, 1), cB + hstep + kstep, voffB);
        PG8_WAIT_V(6); PG8_BAR;
    } else {
        PG8_STAGE(PG8_SB(0, 0), cB, voffB); PG8_STAGE(PG8_SA(0, 0), cA, voffA); PG8_STAGE(PG8_SB(0, 1), cB + hstep, voffB); PG8_STAGE(PG8_SA(0, 1), cA + hstep, voffA);
        if (wr == 1) PG8_BAR;
        PG8_WAIT_V(4); PG8_BAR;
        PG8_STAGE(PG8_SB(1, 0), cB + kstep, voffB); PG8_STAGE(PG8_SA(1, 0), cA + kstep, voffA); PG8_STAGE(PG8_SB(1, 1), cB + hstep + kstep, voffB);
        PG8_WAIT_V(6); PG8_BAR;
    }
    for (;;) {
        const bool has_next = S.next(ui + 1, nxt);
        const char* nA = has_next ? (const char*)g.A + (size_t)nxt.pm * tstep : cA; const char* nB = has_next ? (const char*)g.Bt + (size_t)nxt.pn * tstep : cB;
        for (int t = 0; t < nt; t += 2) {
            const bool last = (t == nt - 2);
            const char* a1 = cA + (size_t)(t + 1) * kstep;
            const char* a2 = last ? nA : cA + (size_t)(t + 2) * kstep; const char* b2 = last ? nB : cB + (size_t)(t + 2) * kstep;
            const char* a3 = a2 + kstep; const char* b3 = b2 + kstep;
            if (last && has_next) S.a_ready(nxt);
            if constexpr (SP2) {
            PG8_LDB(B0, 0, 0); PG8_LDB(B1, 0, 1); PG8_SCHED; PG8_LDA(At, 0, 0); PG8_STAGE(PG8_SA(1, 1), a1 + hstep, voffA);
            PG8_WAIT_V(8); PG8_WAIT_L(0); PG8_BAR; PG8_MMA(0, 0, At, B0); PG8_MMA(0, 1, At, B1); PG8_BAR; PG8_SCHED;
            PG8_LDA(At, 0, 1); PG8_STAGE(PG8_SB(0, 0), b2, voffB); PG8_STAGE(PG8_SB(0, 1), b2 + hstep, voffB); PG8_STAGE(PG8_SA(0, 0), a2, voffA);
            PG8_WAIT_V(8); PG8_WAIT_L(0); PG8_BAR; PG8_MMA(1, 0, At, B0); PG8_MMA(1, 1, At, B1); PG8_BAR; PG8_SCHED;
            PG8_LDB(B0, 1, 0); PG8_LDB(B1, 1, 1); PG8_SCHED; PG8_LDA(At, 1, 0); PG8_STAGE(PG8_SA(0, 1), a2 + hstep, voffA);
            PG8_WAIT_V(8); PG8_WAIT_L(0); PG8_BAR; PG8_MMA(0, 0, At, B0); PG8_MMA(0, 1, At, B1); PG8_BAR; PG8_SCHED;
            PG8_LDA(At, 1, 1); PG8_STAGE(PG8_SB(1, 0), b3, voffB); PG8_STAGE(PG8_SB(1, 1), b3 + hstep, voffB); PG8_STAGE(PG8_SA(1, 0), a3, voffA);
            PG8_WAIT_V(8); PG8_WAIT_L(0); PG8_BAR; PG8_MMA(1, 0, At, B0); PG8_MMA(1, 1, At, B1); PG8_BAR; PG8_SCHED;
            } else {
            PG8_LDB(B0, 0, 0); PG8_SCHED; PG8_LDA(At, 0, 0); PG8_STAGE(PG8_SA(1, 1), a1 + hstep, voffA);
            PG8_WAIT_L(8); PG8_BAR; PG8_WAIT_L(0); PG8_MMA(0, 0, At, B0); PG8_BAR; PG8_SCHED;
            PG8_LDB(B1, 0, 1); PG8_STAGE(PG8_SB(0, 0), b2, voffB);
            PG8_BAR; PG8_WAIT_L(0); PG8_MMA(0, 1, At, B1); PG8_BAR;
            PG8_LDA(At, 0, 1); PG8_STAGE(PG8_SA(0, 0), a2, voffA);
            PG8_BAR; PG8_WAIT_L(0); PG8_MMA(1, 0, At, B0); PG8_BAR; PG8_SCHED;
            PG8_STAGE(PG8_SB(0, 1), b2 + hstep, voffB);
            PG8_WAIT_V(6); PG8_BAR; PG8_MMA(1, 1, At, B1); PG8_BAR;
            PG8_LDB(B0, 1, 0); PG8_SCHED; PG8_LDA(At, 1, 0); PG8_STAGE(PG8_SA(0, 1), a2 + hstep, voffA);
            PG8_WAIT_L(8); PG8_BAR; PG8_WAIT_L(0); PG8_MMA(0, 0, At, B0); PG8_BAR; PG8_SCHED;
            PG8_LDB(B1, 1, 1); PG8_STAGE(PG8_SB(1, 0), b3, voffB);
            PG8_BAR; PG8_WAIT_L(0); PG8_MMA(0, 1, At, B1); PG8_BAR;
            PG8_LDA(At, 1, 1); PG8_STAGE(PG8_SA(1, 0), a3, voffA);
            PG8_BAR; PG8_WAIT_L(0); PG8_MMA(1, 0, At, B0); PG8_BAR; PG8_SCHED;
            PG8_STAGE(PG8_SB(1, 1), b3 + hstep, voffB);
            PG8_WAIT_V(6); PG8_BAR; PG8_MMA(1, 1, At, B1); PG8_BAR;
            }
        }
        if constexpr (ALIGN_EPI) { if (wr == 0) PG8_BAR; }
        if constexpr (!Epi::AFTER_DRAIN) { E(acc, cur, wr, wc, fr, fq); S.done(cur); }
        if (!has_next) break;
#pragma unroll
        for (int a = 0; a < 2; ++a)
#pragma unroll
            for (int b = 0; b < 2; ++b)
#pragma unroll
                for (int m = 0; m < 4; ++m)
#pragma unroll
                    for (int n = 0; n < 2; ++n) acc[a][b][m][n] = (f32x4){0.f, 0.f, 0.f, 0.f};
        cur = nxt; cA = nA; cB = nB; ++ui;
        if constexpr (ALIGN_EPI) { if (wr == 1) PG8_BAR; }
    }
    PG8_WAIT_V(0);
    if constexpr (!ALIGN_EPI) { if (wr == 0) PG8_BAR; }
    PG8_BAR;
    if constexpr (Epi::AFTER_DRAIN) { E.fused(acc, cur, wr, wc, fr, fq, lds, wid, lane); S.done(cur); }
#undef PG8_SA
#undef PG8_SB
#undef PG8_STAGE
#undef PG8_LDA
#undef PG8_LDB
#undef PG8_MMA
#undef PG8_WAIT_V
#undef PG8_WAIT_L
#undef PG8_BAR
#undef PG8_SCHED
}
}

__device__ __forceinline__ void phase_conv(const Args& a, int bid, int nb) {
    const int tid = threadIdx.x, lane = tid & 63, wave = tid >> 6;
    const int gw = bid * NWAVES + wave, NGW = nb * NWAVES;
    const bf16* PROJ = (const bf16*)(a.ws + WS_PROJ);
    const bf16* U = (const bf16*)(a.ws + WS_U);
    const bf16* WDT = (const bf16*)(a.ws + WS_WDT_T);
    bf16* XB = (bf16*)(a.ws + WS_XBC);
    bf16* MG = (bf16*)(a.ws + WS_MERGED);
    float* DT = (float*)(a.ws + WS_DT);
    const float* scw = a.in[I_SCW]; const float* scb = a.in[I_SCB]; const float* cw = a.in[I_CONVW];
    for (int row = gw; row < MALL; row += NGW) {
        const bool lat = row < MLAT;
        const int pos = lat ? (row & 63) : ((row - MLAT) & 255), len = lat ? 64 : 256;
        const bool hasL = pos > 0, hasR = pos < len - 1;
        const bf16* P = PROJ + (size_t)row * NPROJ;
#pragma unroll
        for (int half = 0; half < 2; ++half) {
            const int ch0 = lane * 16 + half * 8;
            if (!lat && ch0 >= 768) continue;
            const v4u zc = {0u, 0u, 0u, 0u};
            const v4u cu = *(const v4u*)(P + XBC_OFF + ch0);
            const v4u le = hasL ? *(const v4u*)(P - NPROJ + XBC_OFF + ch0) : zc;
            const v4u ri = hasR ? *(const v4u*)(P + NPROJ + XBC_OFF + ch0) : zc;
            float o[8];
#pragma unroll
            for (int i = 0; i < 8; ++i) {
                const unsigned wc = i < 2 ? cu.x : i < 4 ? cu.y : i < 6 ? cu.z : cu.w;
                const unsigned wl = i < 2 ? le.x : i < 4 ? le.y : i < 6 ? le.z : le.w;
                const unsigned wr = i < 2 ? ri.x : i < 4 ? ri.y : i < 6 ? ri.z : ri.w;
                const float c = (i & 1) ? bfhi(wc) : bflo(wc), l = (i & 1) ? bfhi(wl) : bflo(wl), r = (i & 1) ? bfhi(wr) : bflo(wr);
                const int ch = ch0 + i;
                const float v = scw[ch] * l + scw[XBC + ch] * c + scw[2 * XBC + ch] * r + scb[ch];
                o[i] = silu_f(v);
            }
            v4u w; w.x = pk2(o[0], o[1]); w.y = pk2(o[2], o[3]); w.z = pk2(o[4], o[5]); w.w = pk2(o[6], o[7]);
            *(v4u*)(XB + (size_t)row * XBC + ch0) = w;
        }
        if (lat) {
            const int ch0 = lane * 8;
            const v4u zc = {0u, 0u, 0u, 0u};
            const v4u gb = *(const v4u*)(P + ch0);
            const v4u gc0 = *(const v4u*)(P + CONVW + ch0), gh0 = *(const v4u*)(P + 2 * CONVW + ch0);
            const v4u gcl = hasL ? *(const v4u*)(P - NPROJ + CONVW + ch0) : zc, ghl = hasL ? *(const v4u*)(P - NPROJ + 2 * CONVW + ch0) : zc;
            const v4u gcr = hasR ? *(const v4u*)(P + NPROJ + CONVW + ch0) : zc, ghr = hasR ? *(const v4u*)(P + NPROJ + 2 * CONVW + ch0) : zc;
            float o[8];
#pragma unroll
            for (int i = 0; i < 8; ++i) {
#define SEL(v) ((i & 1) ? bfhi(i < 2 ? v.x : i < 4 ? v.y : i < 6 ? v.z : v.w) : bflo(i < 2 ? v.x : i < 4 ? v.y : i < 6 ? v.z : v.w))
                const int ch = ch0 + i;
                const float pl = SEL(gcl) * SEL(ghl), pc = SEL(gc0) * SEL(gh0), pr = SEL(gcr) * SEL(ghr);
                o[i] = SEL(gb) * (cw[ch] * pl + cw[CONVW + ch] * pc + cw[2 * CONVW + ch] * pr);
#undef SEL
            }
            v4u w; w.x = pk2(o[0], o[1]); w.y = pk2(o[2], o[3]); w.z = pk2(o[4], o[5]); w.w = pk2(o[6], o[7]);
            *(v4u*)(MG + (size_t)row * D + ch0) = w;
        }
        {
            const v4u u0 = *(const v4u*)(U + (size_t)row * D + lane * 16), u1 = *(const v4u*)(U + (size_t)row * D + lane * 16 + 8);
            float uf[16];
            uf[0] = bflo(u0.x); uf[1] = bfhi(u0.x); uf[2] = bflo(u0.y); uf[3] = bfhi(u0.y); uf[4] = bflo(u0.z); uf[5] = bfhi(u0.z); uf[6] = bflo(u0.w); uf[7] = bfhi(u0.w);
            uf[8] = bflo(u1.x); uf[9] = bfhi(u1.x); uf[10] = bflo(u1.y); uf[11] = bfhi(u1.y); uf[12] = bflo(u1.z); uf[13] = bfhi(u1.z); uf[14] = bflo(u1.w); uf[15] = bfhi(u1.w);
            float mine = 0.f;
#pragma unroll
            for (int j = 0; j < 16; ++j) {
                const v4u w0 = *(const v4u*)(WDT + j * 1024 + lane * 16), w1 = *(const v4u*)(WDT + j * 1024 + lane * 16 + 8);
                float p = uf[0] * bflo(w0.x) + uf[1] * bfhi(w0.x) + uf[2] * bflo(w0.y) + uf[3] * bfhi(w0.y) + uf[4] * bflo(w0.z) + uf[5] * bfhi(w0.z) + uf[6] * bflo(w0.w) + uf[7] * bfhi(w0.w)
                        + uf[8] * bflo(w1.x) + uf[9] * bfhi(w1.x) + uf[10] * bflo(w1.y) + uf[11] * bfhi(w1.y) + uf[12] * bflo(w1.z) + uf[13] * bfhi(w1.z) + uf[14] * bflo(w1.w) + uf[15] * bfhi(w1.w);
                p = wave_sum(p);
                if (lane == j) mine = p;
            }
            if (lane < 16) DT[(size_t)row * 16 + lane] = softplus_f(mine + a.in[I_DTB][lane]);
        }
    }
}

__device__ __forceinline__ void phase_ssd_naive(const Args& a, unsigned char* lds, int bid, int nb) {
    const int tid = threadIdx.x, p = tid >> 3, nq = tid & 7;
    float* sx = (float*)lds;
    float* sB = sx + 64 * 64;
    float* sC = sB + 64 * 128;
    float* sdt = sC + 64 * 128;
    const bf16* XB = (const bf16*)(a.ws + WS_XBC);
    const float* DT = (const float*)(a.ws + WS_DT);
    bf16* YD = (bf16*)(a.ws + WS_YDIR);
    for (int item = bid; item < NBATCH * 2 * NH; item += nb) {
        const int b = item & 7, dir = (item >> 3) & 1, h = item >> 4, g = h >> 2;
        const float ah = -__expf(a.in[I_ALOG][dir * 8 + h]);
        float S[16];
#pragma unroll
        for (int i = 0; i < 16; ++i) S[i] = 0.f;
        for (int blk = 0; blk < 36; ++blk) {
            const bool isctx = blk < 4;
            int bi = isctx ? blk : blk - 4; const int nblk = isctx ? 4 : 32; if (dir) bi = nblk - 1 - bi;
            const int rowbase = isctx ? MLAT + b * CTXL + bi * 64 : b * SEQ + bi * 64;
            __syncthreads();
            { const int idx = tid * 8, t = idx >> 6, p0 = idx & 63;
              const v4u w = *(const v4u*)(XB + (size_t)(rowbase + t) * XBC + h * 64 + p0); float* d = sx + t * 64 + p0;
              d[0] = bflo(w.x); d[1] = bfhi(w.x); d[2] = bflo(w.y); d[3] = bfhi(w.y); d[4] = bflo(w.z); d[5] = bfhi(w.z); d[6] = bflo(w.w); d[7] = bfhi(w.w); }
#pragma unroll
            for (int it = 0; it < 2; ++it) { const int idx = tid * 8 + it * 4096, t = idx >> 7, n0 = idx & 127;
              { const v4u w = *(const v4u*)(XB + (size_t)(rowbase + t) * XBC + 512 + g * 128 + n0); float* d = sB + t * 128 + n0;
                d[0] = bflo(w.x); d[1] = bfhi(w.x); d[2] = bflo(w.y); d[3] = bfhi(w.y); d[4] = bflo(w.z); d[5] = bfhi(w.z); d[6] = bflo(w.w); d[7] = bfhi(w.w); }
              if (!isctx) { const v4u w = *(const v4u*)(XB + (size_t)(rowbase + t) * XBC + 768 + g * 128 + n0); float* d = sC + t * 128 + n0;
                d[0] = bflo(w.x); d[1] = bfhi(w.x); d[2] = bflo(w.y); d[3] = bfhi(w.y); d[4] = bflo(w.z); d[5] = bfhi(w.z); d[6] = bflo(w.w); d[7] = bfhi(w.w); } }
            if (tid < 64) sdt[tid] = DT[(size_t)(rowbase + tid) * 16 + dir * 8 + h];
            __syncthreads();
            for (int tt = 0; tt < 64; ++tt) {
                const int t = dir ? 63 - tt : tt;
                const float dtv = sdt[t], dA = __expf(dtv * ah), xv = sx[t * 64 + p] * dtv;
                float y = 0.f;
#pragma unroll
                for (int i = 0; i < 16; ++i) { S[i] = dA * S[i] + xv * sB[t * 128 + nq * 16 + i]; if (!isctx) y += S[i] * sC[t * 128 + nq * 16 + i]; }
                if (!isctx) {
                    y += __shfl_xor(y, 1); y += __shfl_xor(y, 2); y += __shfl_xor(y, 4);
                    if (nq == 0) YD[(size_t)dir * MLAT * SSDW + (size_t)(rowbase + t) * SSDW + h * 64 + p] = (bf16)f2bf(y);
                }
            }
        }
    }
}


typedef short bf16x8 __attribute__((ext_vector_type(8)));
__device__ __forceinline__ void tr_read2(unsigned a0, unsigned a1, v2u& r0, v2u& r1) {
    asm volatile("ds_read_b64_tr_b16 %0, %2\n\tds_read_b64_tr_b16 %1, %3\n\ts_waitcnt lgkmcnt(0)" : "=&v"(r0), "=&v"(r1) : "v"(a0), "v"(a1) : "memory");
}
__device__ __forceinline__ unsigned cvtpk(float lo, float hi) { unsigned r; asm volatile("v_cvt_pk_bf16_f32 %0, %1, %2" : "=v"(r) : "v"(lo), "v"(hi)); return r; }
__device__ __forceinline__ bf16x8 mk_frag(unsigned a, unsigned b, unsigned c, unsigned d) { v4u f = {a, b, c, d}; return __builtin_bit_cast(bf16x8, f); }

__device__ __forceinline__ void phase_ssd(const Args& a, unsigned char* lds_g, int bid, int nb) {
    const int tid = threadIdx.x, lane = tid & 63, w = __builtin_amdgcn_readfirstlane(tid >> 6), i = lane & 15, g = lane >> 4, q = i >> 2, pp = i & 3;
    constexpr int BP = 272, XP = 80, XS_OFF = 34816, SS_OFF = 45056, SS_SZ = 8704, AR_OFF = 62464;
    LAS unsigned char* lds = (LAS unsigned char*)lds_g;
    LAS unsigned char* Bs = lds; LAS unsigned char* Xs = lds + XS_OFF; LAS unsigned char* Ss = lds + SS_OFF;
    LAS float* csA = (LAS float*)(lds + AR_OFF); LAS float* dtA = csA + 128; LAS float* wA = dtA + 128; LAS float* totA = wA + 128;
    const unsigned ldsb = (unsigned)(size_t)lds_g;
    const bf16* XB = (const bf16*)(a.ws + WS_XBC);
    const float* DT = (const float*)(a.ws + WS_DT);
    bf16* YD = (bf16*)(a.ws + WS_YDIR);
    for (int item = bid; item < 256; item += nb) {
        const int b = item & 7, rest = item >> 3, dir = rest & 1, h = (rest >> 1) & 7, ph = rest >> 4, grp = h >> 2;
        const float ah = -__expf(a.in[I_ALOG][dir * 8 + h]);
        f32x4 Sacc[2]; Sacc[0] = (f32x4){0.f, 0.f, 0.f, 0.f}; Sacc[1] = Sacc[0];
        __syncthreads();
        for (int k = tid; k < SS_SZ / 4; k += NT) ((LAS unsigned*)Ss)[k] = 0u;
        v4u pB[4], pX, pC[4]; float pdt0 = 0.f, pdt1 = 0.f;
#define SSD_ROWBASE(c) ((c) < 2 ? MLAT + b * CTXL + (dir ? 1 - (c) : (c)) * 128 : b * SEQ + (dir ? 15 - ((c) - 2) : ((c) - 2)) * 128)
#define SSD_PREFETCH(c) do { const int rb_ = SSD_ROWBASE(c); \
        _Pragma("unroll") for (int k = 0; k < 4; ++k) { const int piece = tid + 512 * k, row = piece >> 4, c16 = piece & 15; \
            pB[k] = *(const v4u*)(XB + (size_t)(rb_ + row) * XBC + 512 + grp * 128 + c16 * 8); } \
        { const int row = tid >> 2, cc = tid & 3; pX = *(const v4u*)(XB + (size_t)(rb_ + row) * XBC + h * 64 + ph * 32 + cc * 8); } \
        if ((c) >= 2) { _Pragma("unroll") for (int ks = 0; ks < 4; ++ks) pC[ks] = *(const v4u*)(XB + (size_t)(rb_ + 16 * w + i) * XBC + 768 + grp * 128 + 32 * ks + 8 * g); } \
        if (w == 0) { pdt0 = DT[(size_t)(rb_ + lane) * 16 + dir * 8 + h]; pdt1 = DT[(size_t)(rb_ + 64 + lane) * 16 + dir * 8 + h]; } } while (0)
        SSD_PREFETCH(0);
        for (int c = 0; c < 18; ++c) {
            const bool isctx = c < 2;
            const int rb = SSD_ROWBASE(c);
            __syncthreads();
#pragma unroll
            for (int k = 0; k < 4; ++k) { const int piece = tid + 512 * k, row = piece >> 4, c16 = piece & 15; *(LAS v4u*)(Bs + row * BP + c16 * 16) = pB[k]; }
            { const int row = tid >> 2, cc = tid & 3; *(LAS v4u*)(Xs + row * XP + cc * 16) = pX; }
            bf16x8 cfrag[4];
#pragma unroll
            for (int ks = 0; ks < 4; ++ks) cfrag[ks] = __builtin_bit_cast(bf16x8, pC[ks]);
            if (w == 0) {
                const float d0 = pdt0, d1 = pdt1, a0 = d0 * ah, a1 = d1 * ah;
                float s0 = a0, s1 = a1;
#pragma unroll
                for (int o = 1; o < 64; o <<= 1) { const float t0 = __shfl_up(s0, o), t1 = __shfl_up(s1, o); if (lane >= o) { s0 += t0; s1 += t1; } }
                const float sum0 = __shfl(s0, 63); s1 += sum0; const float tot = __shfl(s1, 63);
                const float c0 = dir ? tot - s0 + a0 : s0, c1 = dir ? tot - s1 + a1 : s1;
                csA[lane] = c0; csA[64 + lane] = c1; dtA[lane] = d0; dtA[64 + lane] = d1;
                wA[lane] = d0 * __expf(fminf(tot - c0, 0.f)); wA[64 + lane] = d1 * __expf(fminf(tot - c1, 0.f));
                if (lane == 0) totA[0] = tot;
            }
            __syncthreads();
            if (c + 1 < 18) SSD_PREFETCH(c + 1);
            const float csl = csA[16 * w + i], tot = totA[0];
            LAS unsigned char* Sr = Ss + (c & 1) * SS_SZ; LAS unsigned char* Sw = Ss + ((c + 1) & 1) * SS_SZ;
            if (!isctx) {
                f32x4 Y[2]; Y[0] = (f32x4){0.f, 0.f, 0.f, 0.f}; Y[1] = Y[0];
#pragma unroll
                for (int pt = 0; pt < 2; ++pt)
#pragma unroll
                    for (int ks = 0; ks < 4; ++ks) { const bf16x8 af = *(const LAS bf16x8*)(Sr + (16 * pt + i) * BP + (32 * ks + 8 * g) * 2);
                        Y[pt] = __builtin_amdgcn_mfma_f32_16x16x32_bf16(af, cfrag[ks], Y[pt], 0, 0, 0); }
                const float el = __expf(fminf(csl, 0.f));
                Y[0] = Y[0] * el; Y[1] = Y[1] * el;
                const int pj0 = dir ? (w >> 1) : 0, pj1 = dir ? 3 : (w >> 1);
                const int l = 16 * w + i;
                for (int pj = pj0; pj <= pj1; ++pj) {
                    unsigned mh[4];
#pragma unroll
                    for (int t = 0; t < 2; ++t) { const int sb = 2 * pj + t;
                        f32x4 G = (f32x4){0.f, 0.f, 0.f, 0.f};
#pragma unroll
                        for (int ks = 0; ks < 4; ++ks) { const bf16x8 bfr = *(const LAS bf16x8*)(Bs + (16 * sb + i) * BP + (32 * ks + 8 * g) * 2);
                            G = __builtin_amdgcn_mfma_f32_16x16x32_bf16(bfr, cfrag[ks], G, 0, 0, 0); }
                        const f32x4 cs4 = *(const LAS f32x4*)(csA + 16 * sb + 4 * g), dt4 = *(const LAS f32x4*)(dtA + 16 * sb + 4 * g);
                        float m[4];
#pragma unroll
                        for (int j = 0; j < 4; ++j) { const int s = 16 * sb + 4 * g + j; const bool valid = dir ? (s >= l) : (s <= l);
                            const float e = __expf(fminf(csl - cs4[j], 0.f)); m[j] = valid ? G[j] * e * dt4[j] : 0.f; }
                        mh[2 * t] = cvtpk(m[0], m[1]); mh[2 * t + 1] = cvtpk(m[2], m[3]); }
                    const bf16x8 bm = mk_frag(mh[0], mh[1], mh[2], mh[3]);
#pragma unroll
                    for (int pt = 0; pt < 2; ++pt) { const unsigned a0 = ldsb + XS_OFF + (32 * pj + 4 * g + q) * XP + (16 * pt + 4 * pp) * 2; v2u r0, r1; tr_read2(a0, a0 + 16 * XP, r0, r1);
                        Y[pt] = __builtin_amdgcn_mfma_f32_16x16x32_bf16(mk_frag(r0.x, r0.y, r1.x, r1.y), bm, Y[pt], 0, 0, 0); }
                }
#pragma unroll
                for (int pt = 0; pt < 2; ++pt) { v2u o; o.x = cvtpk(Y[pt][0], Y[pt][1]); o.y = cvtpk(Y[pt][2], Y[pt][3]);
                    *(v2u*)(YD + (size_t)dir * MLAT * SSDW + (size_t)(rb + l) * SSDW + h * 64 + ph * 32 + 16 * pt + 4 * g) = o; }
            }
            { const float dtot = __expf(fminf(tot, 0.f)); Sacc[0] = Sacc[0] * dtot; Sacc[1] = Sacc[1] * dtot; }
#pragma unroll
            for (int ks = 0; ks < 4; ++ks) {
                const unsigned ab0 = ldsb + (32 * ks + 8 * g + q) * BP + (16 * w + 4 * pp) * 2; v2u b0, b1; tr_read2(ab0, ab0 + 4 * BP, b0, b1);
                const bf16x8 bfr = mk_frag(b0.x, b0.y, b1.x, b1.y);
                const f32x4 w4a = *(const LAS f32x4*)(wA + 32 * ks + 8 * g), w4b = *(const LAS f32x4*)(wA + 32 * ks + 8 * g + 4);
#pragma unroll
                for (int pt = 0; pt < 2; ++pt) { const unsigned ax0 = ldsb + XS_OFF + (32 * ks + 8 * g + q) * XP + (16 * pt + 4 * pp) * 2; v2u r0, r1; tr_read2(ax0, ax0 + 4 * XP, r0, r1);
                    const unsigned f0 = cvtpk(bflo(r0.x) * w4a[0], bfhi(r0.x) * w4a[1]), f1 = cvtpk(bflo(r0.y) * w4a[2], bfhi(r0.y) * w4a[3]);
                    const unsigned f2 = cvtpk(bflo(r1.x) * w4b[0], bfhi(r1.x) * w4b[1]), f3 = cvtpk(bflo(r1.y) * w4b[2], bfhi(r1.y) * w4b[3]);
                    Sacc[pt] = __builtin_amdgcn_mfma_f32_16x16x32_bf16(mk_frag(f0, f1, f2, f3), bfr, Sacc[pt], 0, 0, 0); }
            }
#pragma unroll
            for (int pt = 0; pt < 2; ++pt)
#pragma unroll
                for (int j = 0; j < 4; ++j) *(LAS bf16*)(Sw + (16 * pt + 4 * g + j) * BP + (16 * w + i) * 2) = (bf16)f2bf(Sacc[pt][j]);
        }
#undef SSD_PREFETCH
#undef SSD_ROWBASE
    }
}
__device__ __forceinline__ void phase_fin(const Args& a, int bid, int nb) {
    const int tid = threadIdx.x, lane = tid & 63, wave = tid >> 6;
    const int gw = bid * NWAVES + wave, NGW = nb * NWAVES;
    const bf16* PROJ = (const bf16*)(a.ws + WS_PROJ);
    const bf16* XB = (const bf16*)(a.ws + WS_XBC);
    const bf16* YD = (const bf16*)(a.ws + WS_YDIR);
    bf16* MG = (bf16*)(a.ws + WS_MERGED);
    for (int row = gw; row < MLAT; row += NGW) {
        const int ch0 = lane * 8;
        const v4u yf = *(const v4u*)(YD + (size_t)row * SSDW + ch0), yb = *(const v4u*)(YD + (size_t)MLAT * SSDW + (size_t)row * SSDW + ch0);
        const v4u xs = *(const v4u*)(XB + (size_t)row * XBC + ch0), zz = *(const v4u*)(PROJ + (size_t)row * NPROJ + Z_OFF + ch0);
        const float dd = a.in[I_SSDD][ch0 >> 6];
        float o[8]; float ss = 0.f;
#pragma unroll
        for (int i = 0; i < 8; ++i) {
#define SEL(v) ((i & 1) ? bfhi(i < 2 ? v.x : i < 4 ? v.y : i < 6 ? v.z : v.w) : bflo(i < 2 ? v.x : i < 4 ? v.y : i < 6 ? v.z : v.w))
            const float y = SEL(yf) + SEL(yb) + SEL(xs) * dd;
            const float yg = y * silu_f(SEL(zz));
#undef SEL
            o[i] = yg; ss += yg * yg;
        }
        const float r = rsqrtf(wave_sum(ss) * (1.f / SSDW) + RMS_EPS);
        const float* nw = a.in[I_SNW] + ch0;
        v4u w; w.x = pk2(o[0] * r * nw[0], o[1] * r * nw[1]); w.y = pk2(o[2] * r * nw[2], o[3] * r * nw[3]);
        w.z = pk2(o[4] * r * nw[4], o[5] * r * nw[5]); w.w = pk2(o[6] * r * nw[6], o[7] * r * nw[7]);
        *(v4u*)(MG + (size_t)row * D + SSDW + ch0) = w;
    }
}

__device__ __forceinline__ void phase_ln1(const Args& a, int bid, int nb) {
    const int tid = threadIdx.x, lane = tid & 63, wave = tid >> 6;
    const int gw = bid * NWAVES + wave, NGW = nb * NWAVES;
    const float* MOD = (const float*)(a.ws + WS_MOD);
    const float* V = (const float*)(a.ws + WS_V1PRE);
    bf16* H1 = (bf16*)(a.ws + WS_H1); bf16* U2 = (bf16*)(a.ws + WS_U2);
    for (int row = gw; row < MLAT; row += NGW) {
        const int r = row / SEQ;
        const f32x4* xr = (const f32x4*)(V + (size_t)row * D) + lane;
        f32x4 v[4]; float s = 0.f;
#pragma unroll
        for (int j = 0; j < 4; ++j) { v[j] = xr[64 * j]; s += (v[j].x + v[j].y) + (v[j].z + v[j].w); }
        const float mean = wave_sum(s) * (1.f / D); float s2 = 0.f;
#pragma unroll
        for (int j = 0; j < 4; ++j) { v[j] = v[j] - mean; s2 += (v[j].x * v[j].x + v[j].y * v[j].y) + (v[j].z * v[j].z + v[j].w * v[j].w); }
        const float rstd = 1.f / sqrtf(wave_sum(s2) * (1.f / D) + LN_EPS);
        v2u* oh = (v2u*)(H1 + (size_t)row * D) + lane; v2u* ou = (v2u*)(U2 + (size_t)row * D) + lane;
#pragma unroll
        for (int j = 0; j < 4; ++j) {
            const int c = 4 * (lane + 64 * j);
            const f32x4 g = *(const f32x4*)(a.in[I_LN1G] + c), bb = *(const f32x4*)(a.in[I_LN1B] + c);
            const f32x4 sh = *(const f32x4*)(MOD + r * 6144 + 3072 + c), sc = *(const f32x4*)(MOD + r * 6144 + 4096 + c);
            const f32x4 h = v[j] * rstd * g + bb;
            const f32x4 u = h * (1.f + sc) + sh;
            v2u w; w.x = pk2(h.x, h.y); w.y = pk2(h.z, h.w); oh[64 * j] = w;
            v2u w2; w2.x = pk2(u.x, u.y); w2.y = pk2(u.z, u.w); ou[64 * j] = w2;
        }
    }
}
__device__ __forceinline__ void phase_ln2(const Args& a, int bid, int nb) {
    const int tid = threadIdx.x, lane = tid & 63, wave = tid >> 6;
    const int gw = bid * NWAVES + wave, NGW = nb * NWAVES;
    for (int row = gw; row < MLAT; row += NGW) {
        f32x4* xr = (f32x4*)(a.out + (size_t)row * D) + lane;
        f32x4 v[4]; float s = 0.f;
#pragma unroll
        for (int j = 0; j < 4; ++j) { v[j] = xr[64 * j]; s += (v[j].x + v[j].y) + (v[j].z + v[j].w); }
        const float mean = wave_sum(s) * (1.f / D); float s2 = 0.f;
#pragma unroll
        for (int j = 0; j < 4; ++j) { v[j] = v[j] - mean; s2 += (v[j].x * v[j].x + v[j].y * v[j].y) + (v[j].z * v[j].z + v[j].w * v[j].w); }
        const float rstd = 1.f / sqrtf(wave_sum(s2) * (1.f / D) + LN_EPS);
#pragma unroll
        for (int j = 0; j < 4; ++j) {
            const int c = 4 * (lane + 64 * j);
            const f32x4 g = *(const f32x4*)(a.in[I_LN2G] + c), bb = *(const f32x4*)(a.in[I_LN2B] + c);
            xr[64 * j] = v[j] * rstd * g + bb;
        }
    }
}

__global__ void __launch_bounds__(NT, 2) mk_fwd(Args a) {
    extern __shared__ __attribute__((aligned(16))) unsigned char lds[];
    const int bid = blockIdx.x, nb = gridDim.x;
    const int lo = a.ph_lo, hi = a.ph_hi;
    unsigned char* ws = a.ws;
#define IN(k) (lo <= (k) && (k) < hi)
#define SEAM(k) do { if (IN(k) && IN((k) + 1)) { cg::this_grid().sync(); } } while (0)
    if (IN(0)) phase_p0a(a, lds, bid, nb);
    SEAM(0);
    if (IN(1)) phase_p0b(a, bid, nb);
    SEAM(1);
    if (IN(2)) {
        pg8::Gemm g{(const bf16*)(ws + WS_U), (const bf16*)(ws + WS_WIN_T), MALL, NPROJ, D}; pg8::InProjOrder S; S.init(nb, bid);
        pg8::EpiBf16<0> E{(bf16*)(ws + WS_PROJ), NPROJ};
        pg8::gemm_phase<pg8::EpiBf16<0>, pg8::InProjOrder, true, true>((LAS unsigned char*)lds, g, S, E);
    }
    SEAM(2);
    if (IN(3)) phase_conv(a, bid, nb);
    SEAM(3);
    if (IN(4)) phase_ssd(a, lds, bid, nb);
    SEAM(4);
    if (IN(5)) phase_fin(a, bid, nb);
    SEAM(5);
    if (IN(6)) {
        pg8::Gemm g{(const bf16*)(ws + WS_MERGED), (const bf16*)(ws + WS_WOUT_T), MLAT, D, D}; pg8::StaticOrder S; S.init(MLAT, D, nb, bid);
        pg8::EpiRes1 E{a.in[I_X], (const float*)(ws + WS_STATS), a.in[I_LNG], a.in[I_LNB], (const float*)(ws + WS_MOD) + 2048, (float*)(ws + WS_V1PRE), ALPHA};
        pg8::gemm_phase<pg8::EpiRes1, pg8::StaticOrder, true, true>((LAS unsigned char*)lds, g, S, E);
    }
    SEAM(6);
    if (IN(7)) phase_ln1(a, bid, nb);
    SEAM(7);
    if (IN(8)) {
        pg8::Gemm g{(const bf16*)(ws + WS_U2), (const bf16*)(ws + WS_WFF1_T), MLAT, FF, D}; pg8::StaticOrder S; S.init(MLAT, FF, nb, bid);
        pg8::EpiBf16<1> E{(bf16*)(ws + WS_ACT), FF};
        pg8::gemm_phase<pg8::EpiBf16<1>, pg8::StaticOrder, true, true>((LAS unsigned char*)lds, g, S, E);
    }
    SEAM(8);
    if (IN(9)) {
        pg8::Gemm g{(const bf16*)(ws + WS_ACT), (const bf16*)(ws + WS_WFF2_T), MLAT, D, FF}; pg8::StaticOrder S; S.init(MLAT, D, nb, bid);
        pg8::EpiRes2 E{(const bf16*)(ws + WS_H1), (const float*)(ws + WS_MOD) + 5120, a.out, ALPHA};
        pg8::gemm_phase<pg8::EpiRes2, pg8::StaticOrder, true, true>((LAS unsigned char*)lds, g, S, E);
    }
    SEAM(9);
    if (IN(10)) phase_ln2(a, bid, nb);
#undef IN
#undef SEAM
}

extern "C" void kernel_launch(void* const* d_in, const int* in_sizes, int n_in, void* d_out, int out_size, void* d_ws, size_t ws_size, hipStream_t stream) {
    static int grid = 0;
    if (grid == 0) {
        if (n_in != 23 || out_size != MLAT * D || ws_size < WS_END) { fprintf(stderr, "kernel_launch: unexpected shapes n_in %d out %d ws %zu\n", n_in, out_size, ws_size); grid = -1; return; }
        int dev = 0, cus = 0, per_cu = 0;
        (void)hipGetDevice(&dev);
        (void)hipDeviceGetAttribute(&cus, hipDeviceAttributeMultiprocessorCount, dev);
        (void)hipFuncSetAttribute((const void*)mk_fwd, hipFuncAttributeMaxDynamicSharedMemorySize, LDS_BYTES);
        (void)hipOccupancyMaxActiveBlocksPerMultiprocessor(&per_cu, (const void*)mk_fwd, NT, LDS_BYTES);
        (void)hipGetLastError();
        if (per_cu < 1) { fprintf(stderr, "kernel_launch: occupancy query says %d blocks/CU\n", per_cu); per_cu = 1; }
        grid = cus;
    }
    if (grid < 0) return;
    Args a{};
    for (int i = 0; i < 23; ++i) a.in[i] = (const float*)d_in[i];
    a.out = (float*)d_out; a.ws = (unsigned char*)d_ws;
#if ONE_LAUNCH
    a.ph_lo = 0; a.ph_hi = NPHASES;
    void* args[] = {&a};
    hipError_t e = hipLaunchCooperativeKernel((const void*)mk_fwd, dim3(grid), dim3(NT), args, LDS_BYTES, stream);
    if (e != hipSuccess) fprintf(stderr, "cooperative launch failed: %s (grid %d)\n", hipGetErrorString(e), grid);
#else
    for (int ph = 0; ph < NPHASES; ++ph) {
        a.ph_lo = ph; a.ph_hi = ph + 1;
        hipLaunchKernelGGL(mk_fwd, dim3(grid), dim3(NT), LDS_BYTES, stream, a);
    }
#endif
}
```

```cpp
#include <hip/hip_runtime.h>
#include <hip/hip_cooperative_groups.h>
#include <cstdio>
#include <cstdint>
namespace cg = cooperative_groups;

#ifndef ONE_LAUNCH
#define ONE_LAUNCH 1
#endif

constexpr int D = 1024, NBATCH = 8, SEQ = 2048, CTXL = 256;
constexpr int MLAT = NBATCH * SEQ, MCTX = NBATCH * CTXL, MALL = MLAT + MCTX;
constexpr int IN_DIM = 3088, NPROJ = 3072, FF = 4096;
constexpr int CONVW = 512, SSDW = 512, XBC = 1024, NH = 8, HD = 64, NS = 128;
constexpr int Z_OFF = 1536, XBC_OFF = 2048;
constexpr float LN_EPS = 1e-5f, RMS_EPS = 1e-5f, ALPHA = 1.189207115002721f;
constexpr int NT = 512, NWAVES = 8, NPHASES = 11;
__device__ constexpr int REP[11] = {1, 1, 1, 1, 1, 1, 1, 1, 1, 1, 1};

constexpr size_t MiB = 1u << 20;
constexpr size_t WS_MOD = 0, WS_STATS = 256 * 1024, WS_BAR = 512 * 1024, BAR_BYTES = 16384;
constexpr size_t WS_WIN_T = 1 * MiB, WS_WDT_T = 7 * MiB, WS_WOUT_T = 8 * MiB, WS_WFF1_T = 10 * MiB, WS_WFF2_T = 18 * MiB;
constexpr size_t WS_U = 26 * MiB, WS_YDIR = 26 * MiB, WS_U2 = 26 * MiB;
constexpr size_t WS_PROJ = 62 * MiB, WS_V1PRE = 62 * MiB, WS_ACT = 62 * MiB;
constexpr size_t WS_XBC = 170 * MiB, WS_DT = 206 * MiB, WS_MERGED = 208 * MiB, WS_H1 = 208 * MiB;
constexpr size_t WS_END = 240 * MiB;
constexpr int LDS_BYTES = 147456, LDS_MISC = 131072 + 64;

typedef unsigned short bf16;
#define LAS __attribute__((address_space(3)))
typedef unsigned v4u __attribute__((ext_vector_type(4)));
typedef unsigned v2u __attribute__((ext_vector_type(2)));
typedef float f32x4 __attribute__((ext_vector_type(4)));

__device__ __forceinline__ float bf2f(unsigned v) { return __uint_as_float(v << 16); }
__device__ __forceinline__ float bflo(unsigned w) { return __uint_as_float(w << 16); }
__device__ __forceinline__ float bfhi(unsigned w) { return __uint_as_float(w & 0xffff0000u); }
__device__ __forceinline__ unsigned f2bf(float f) { unsigned u = __float_as_uint(f); return (u + 0x7fffu + ((u >> 16) & 1u)) >> 16; }
__device__ __forceinline__ unsigned pk2(float lo, float hi) { return f2bf(lo) | (f2bf(hi) << 16); }
__device__ __forceinline__ float wave_sum(float v) {
#pragma unroll
    for (int o = 1; o < 64; o <<= 1) v += __shfl_xor(v, o);
    return v;
}
__device__ __forceinline__ float silu_f(float v) { return v / (1.f + __expf(-v)); }
__device__ __forceinline__ float softplus_f(float v) { return v > 20.f ? v : log1pf(__expf(v)); }

struct Args { const float* in[23]; float* out; unsigned char* ws; int ph_lo, ph_hi; };
enum { I_X = 0, I_C, I_CTX, I_CCTX, I_LNG, I_LNB, I_WMOD, I_BMOD, I_WIN, I_CONVW, I_SCW, I_SCB, I_DTB, I_ALOG, I_SSDD, I_SNW, I_WOUT,
       I_LN1G, I_LN1B, I_WFF1, I_WFF2, I_LN2G, I_LN2B };

__device__ __forceinline__ void transpose_item(const float* W, int ldw, int K, int N, bf16* WT, float* scr, int item, int lane) {
    const int nblk = N / 32, kb = item / nblk, nb = item % nblk, k0 = 64 * kb, n0 = 32 * nb;
#pragma unroll 8
    for (int i = 0; i < 32; ++i) { const int kk = 2 * i + (lane >> 5); scr[kk * 33 + (lane & 31)] = W[(size_t)(k0 + kk) * ldw + n0 + (lane & 31)]; }
    __builtin_amdgcn_s_waitcnt(0); __builtin_amdgcn_wave_barrier();
    const int c = lane & 7;
#pragma unroll
    for (int j = 0; j < 4; ++j) { const int n = (lane >> 3) + 8 * j; const float* s = scr + (8 * c) * 33 + n;
        v4u o; o.x = pk2(s[0 * 33], s[1 * 33]); o.y = pk2(s[2 * 33], s[3 * 33]); o.z = pk2(s[4 * 33], s[5 * 33]); o.w = pk2(s[6 * 33], s[7 * 33]);
        *(v4u*)(WT + (size_t)(n0 + n) * K + k0 + 8 * c) = o; }
    __builtin_amdgcn_s_waitcnt(0); __builtin_amdgcn_wave_barrier();
}

__device__ __forceinline__ void phase_p0a(const Args& a, unsigned char* lds, int bid, int nb) {
    const int tid = threadIdx.x, lane = tid & 63, wave = tid >> 6;
    unsigned char* ws = a.ws;
    if (bid < 192) {
        float* sC = (float*)lds;
        float* part = (float*)(lds + 8192);
        float* MOD = (float*)(ws + WS_MOD);
        for (int item = bid; item < 192; item += nb) {
            const int cgp = item % 24, kc = item / 24;
            for (int i = tid; i < 9 * 128; i += NT) { const int r = i >> 7, k = kc * 128 + (i & 127); const float v = r < 8 ? a.in[I_C][r * 1024 + k] : a.in[I_CCTX][k]; sC[i] = silu_f(v); }
            __syncthreads();
            const float* wm = a.in[I_WMOD] + (size_t)(kc * 128 + wave * 16) * 6144 + cgp * 256 + lane * 4;
            f32x4 wv[16];
#pragma unroll
            for (int k = 0; k < 16; ++k) wv[k] = *(const f32x4*)(wm + (size_t)k * 6144);
            f32x4 acc[9];
#pragma unroll
            for (int r = 0; r < 9; ++r) acc[r] = (f32x4){0.f, 0.f, 0.f, 0.f};
#pragma unroll
            for (int k = 0; k < 16; ++k)
#pragma unroll
                for (int r = 0; r < 9; ++r) acc[r] += wv[k] * sC[r * 128 + wave * 16 + k];
#pragma unroll
            for (int r = 0; r < 9; ++r) *(f32x4*)(part + (wave * 9 + r) * 256 + lane * 4) = acc[r];
            __syncthreads();
            for (int idx = tid; idx < 9 * 256; idx += NT) { const int r = idx >> 8, l = idx & 255; float s = kc == 0 ? a.in[I_BMOD][cgp * 256 + l] : 0.f;
#pragma unroll
                for (int w = 0; w < 8; ++w) s += part[(w * 9 + r) * 256 + l];
                atomicAdd(MOD + r * 6144 + cgp * 256 + l, s); }
            __syncthreads();
        }
    }
    __syncthreads();
    { bf16* WDT = (bf16*)(ws + WS_WDT_T);
      for (int i = bid * NT + tid; i < 16 * 1024; i += nb * NT) { const int j = i >> 10, k = i & 1023; WDT[i] = (bf16)f2bf(a.in[I_WIN][(size_t)k * IN_DIM + NPROJ + j]); } }
    float* scr = (float*)(lds + wave * 16384);
    const int gw = bid * NWAVES + wave, NGW = nb * NWAVES;
    constexpr int IT_IN = 16 * 96, IT_OUT = 16 * 32, IT_F1 = 16 * 128, IT_F2 = 64 * 32, IT_ALL = IT_IN + IT_OUT + IT_F1 + IT_F2;
    for (int it = gw; it < IT_ALL; it += NGW) {
        int r = it;
        if (r < IT_IN) { transpose_item(a.in[I_WIN], IN_DIM, D, NPROJ, (bf16*)(ws + WS_WIN_T), scr, r, lane); continue; } r -= IT_IN;
        if (r < IT_OUT) { transpose_item(a.in[I_WOUT], D, D, D, (bf16*)(ws + WS_WOUT_T), scr, r, lane); continue; } r -= IT_OUT;
        if (r < IT_F1) { transpose_item(a.in[I_WFF1], FF, D, FF, (bf16*)(ws + WS_WFF1_T), scr, r, lane); continue; } r -= IT_F1;
        transpose_item(a.in[I_WFF2], D, FF, D, (bf16*)(ws + WS_WFF2_T), scr, r, lane);
    }
}

__device__ __forceinline__ void phase_p0b(const Args& a, int bid, int nb) {
    const int tid = threadIdx.x, lane = tid & 63, wave = tid >> 6;
    const int gw = bid * NWAVES + wave, NGW = nb * NWAVES;
    const float* MOD = (const float*)(a.ws + WS_MOD);
    float* STATS = (float*)(a.ws + WS_STATS);
    bf16* U = (bf16*)(a.ws + WS_U);
    for (int row = gw; row < MALL; row += NGW) {
        const float* src = row < MLAT ? a.in[I_X] + (size_t)row * D : a.in[I_CTX] + (size_t)(row - MLAT) * D;
        const int r = row < MLAT ? row / SEQ : 8;
        const f32x4* xr = (const f32x4*)src + lane;
        f32x4 v[4]; float s = 0.f;
#pragma unroll
        for (int j = 0; j < 4; ++j) { v[j] = xr[64 * j]; s += (v[j].x + v[j].y) + (v[j].z + v[j].w); }
        const float mean = wave_sum(s) * (1.f / D); float s2 = 0.f;
#pragma unroll
        for (int j = 0; j < 4; ++j) { v[j] = v[j] - mean; s2 += (v[j].x * v[j].x + v[j].y * v[j].y) + (v[j].z * v[j].z + v[j].w * v[j].w); }
        const float rstd = 1.f / sqrtf(wave_sum(s2) * (1.f / D) + LN_EPS);
        if (lane == 0) { STATS[2 * row] = mean; STATS[2 * row + 1] = rstd; }
        v2u* o8 = (v2u*)(U + (size_t)row * D) + lane;
#pragma unroll
        for (int j = 0; j < 4; ++j) {
            const int c = 4 * (lane + 64 * j);
            const f32x4 g = *(const f32x4*)(a.in[I_LNG] + c), bb = *(const f32x4*)(a.in[I_LNB] + c);
            const f32x4 sh = *(const f32x4*)(MOD + r * 6144 + c), sc = *(const f32x4*)(MOD + r * 6144 + 1024 + c);
            const f32x4 h = v[j] * rstd * g + bb;
            const f32x4 u = h * (1.f + sc) + sh;
            v2u w; w.x = pk2(u.x, u.y); w.y = pk2(u.z, u.w); o8[64 * j] = w;
        }
    }
}

template <class Epi, class Ok>
__device__ __forceinline__ void gemm_naive(unsigned char* lds, const bf16* A, const bf16* Bt, int M, int N, int K, int bid, int nb, const Epi& epi, const Ok& ok) {
    float* As = (float*)lds; float* Bs = As + 64 * 33;
    const int tid = threadIdx.x, row = tid >> 3, cgp = tid & 7;
    const int tilesN = N / 64, ntiles = (M / 64) * tilesN;
    for (int tile = bid; tile < ntiles; tile += nb) {
        const int tm = tile / tilesN, tn = tile % tilesN;
        if (!ok(tm, tn)) continue;
        float acc[8];
#pragma unroll
        for (int j = 0; j < 8; ++j) acc[j] = 0.f;
        for (int k0 = 0; k0 < K; k0 += 32) {
            const int r = tid >> 3, c4 = (tid & 7) * 4;
            const v2u av = *(const v2u*)(A + (size_t)(tm * 64 + r) * K + k0 + c4);
            const v2u bv = *(const v2u*)(Bt + (size_t)(tn * 64 + r) * K + k0 + c4);
            __syncthreads();
            As[r * 33 + c4 + 0] = bflo(av.x); As[r * 33 + c4 + 1] = bfhi(av.x); As[r * 33 + c4 + 2] = bflo(av.y); As[r * 33 + c4 + 3] = bfhi(av.y);
            Bs[r * 33 + c4 + 0] = bflo(bv.x); Bs[r * 33 + c4 + 1] = bfhi(bv.x); Bs[r * 33 + c4 + 2] = bflo(bv.y); Bs[r * 33 + c4 + 3] = bfhi(bv.y);
            __syncthreads();
#pragma unroll 8
            for (int k = 0; k < 32; ++k) { const float av1 = As[row * 33 + k];
#pragma unroll
                for (int j = 0; j < 8; ++j) acc[j] += av1 * Bs[(cgp * 8 + j) * 33 + k]; }
        }
#pragma unroll
        for (int j = 0; j < 8; ++j) epi(tm * 64 + row, tn * 64 + cgp * 8 + j, acc[j]);
    }
}

namespace pg8 {
#define PG8_LAS __attribute__((address_space(3)))
typedef unsigned short bf16_t;
typedef short bf16x8 __attribute__((ext_vector_type(8)));
typedef float f32x4 __attribute__((ext_vector_type(4)));
typedef unsigned u32x4 __attribute__((ext_vector_type(4)));
constexpr int BM = 256, BK = 64, HALF = 128, HTB = HALF * BK * 2  , STAGE_BYTES = 8 * HTB, NXCD = 8, WGM = 8;

__host__ __device__ __forceinline__ int lds_byte(int r, int c) { const int st = (r >> 4) * 2 + (c >> 5), rr = r & 15, cc = c & 31, ob = rr * 64 + cc * 2; return st * 1024 + (ob ^ (((ob >> 9) & 1) << 5)); }
__host__ __device__ __forceinline__ void stage_rc(int b, int& R, int& C) { const int st = b / 1024, sb = b % 1024, swz = sb ^ (((sb >> 9) & 1) << 5); R = (st >> 1) * 16 + swz / 64; C = (st & 1) * 32 + (swz % 64) / 2; }
__host__ __device__ __forceinline__ int perm32(int rho) { const int n = rho >> 4, i = rho & 15; return 8 * (i >> 2) + 4 * n + (i & 3); }

struct Unit { int pm, pn; };
struct Gemm { const bf16_t* A; const bf16_t* Bt; int M, N, K; };

struct StaticOrder {
    int nM, nN, nwg, G, c;
    __host__ __device__ void init(int M, int N, int G_, int c_) { nM = M / BM; nN = N / BM; nwg = nM * nN; G = G_; c = c_; }
    __host__ __device__ bool next(int i, Unit& u) const {
        const long L = (long)i * G + c; if (L >= nwg) return false;
        int wgid = (int)L; { const int q = nwg / NXCD, r = nwg % NXCD, xcd = wgid % NXCD, off = wgid / NXCD; wgid = (xcd < r ? xcd * (q + 1) : r * (q + 1) + (xcd - r) * q) + off; }
        const int nig = WGM * nN, gid = wgid / nig, fm = gid * WGM, gsz = (nM - fm) < WGM ? (nM - fm) : WGM;
        u.pm = fm + ((wgid % nig) % gsz); u.pn = (wgid % nig) / gsz; return true;
    }
    __device__ __forceinline__ void a_ready(const Unit&) const {}
    __device__ __forceinline__ void done(const Unit&) const {}
};


__device__ __forceinline__ unsigned cvt_pk_bf16(float lo, float hi) { unsigned r; asm volatile("v_cvt_pk_bf16_f32 %0, %1, %2" : "=v"(r) : "v"(lo), "v"(hi)); return r; }
template <int ACT  > struct EpiBf16 {
    static constexpr bool PERM = true, AFTER_DRAIN = false;
    bf16_t* O; int ldc;
    __device__ __forceinline__ void operator()(const f32x4 (&acc)[2][2][4][2], const Unit& u, int wr, int wc, int fr, int fq) const {
        const int row0 = u.pm * BM + wr * 64 + fr; const int col0 = u.pn * BM + wc * 32 + 8 * fq;
#pragma unroll
        for (int ai = 0; ai < 2; ++ai)
#pragma unroll
            for (int m = 0; m < 4; ++m) { bf16_t* rowp = O + (size_t)(row0 + ai * HALF + m * 16) * ldc + col0;
#pragma unroll
                for (int bj = 0; bj < 2; ++bj) { f32x4 v0 = acc[ai][bj][m][0], v1 = acc[ai][bj][m][1];
                    if (ACT == 1) {
#pragma unroll
                        for (int e = 0; e < 4; ++e) { const float a0 = v0[e] > 0.f ? v0[e] : 0.f, a1 = v1[e] > 0.f ? v1[e] : 0.f; v0[e] = a0 * a0; v1[e] = a1 * a1; } }
                    u32x4 w; w.x = cvt_pk_bf16(v0[0], v0[1]); w.y = cvt_pk_bf16(v0[2], v0[3]); w.z = cvt_pk_bf16(v1[0], v1[1]); w.w = cvt_pk_bf16(v1[2], v1[3]);
                    *(u32x4*)(rowp + bj * HALF) = w; } }
    }
};
struct EpiRes1 {
    static constexpr bool PERM = false, AFTER_DRAIN = false;
    const float* x; const float* stats; const float* lng; const float* lnb; const float* modg; float* V; float alpha;
    __device__ __forceinline__ void operator()(const f32x4 (&acc)[2][2][4][2], const Unit& u, int wr, int wc, int fr, int fq) const {
        const int b = u.pm >> 3; const int colb = u.pn * BM + wc * 32 + 4 * fq;
#pragma unroll
        for (int bj = 0; bj < 2; ++bj)
#pragma unroll
            for (int n = 0; n < 2; ++n) { const int col = colb + bj * HALF + n * 16;
                const f32x4 g = *(const f32x4*)(lng + col), bb = *(const f32x4*)(lnb + col), g1 = *(const f32x4*)(modg + b * 6144 + col);
#pragma unroll
                for (int ai = 0; ai < 2; ++ai)
#pragma unroll
                    for (int m = 0; m < 4; ++m) { const int row = u.pm * BM + ai * HALF + wr * 64 + m * 16 + fr;
                        const float mean = stats[2 * row], rstd = stats[2 * row + 1];
                        const f32x4 xv = *(const f32x4*)(x + (size_t)row * 1024 + col);
                        const f32x4 h = (xv - mean) * rstd * g + bb;
                        *(f32x4*)(V + (size_t)row * 1024 + col) = h * alpha + g1 * acc[ai][bj][m][n]; } }
    }
};
struct EpiRes2 {
    static constexpr bool PERM = false, AFTER_DRAIN = false;
    const bf16_t* H1; const float* modg; float* O; float alpha;
    __device__ __forceinline__ void operator()(const f32x4 (&acc)[2][2][4][2], const Unit& u, int wr, int wc, int fr, int fq) const {
        typedef unsigned u32x2 __attribute__((ext_vector_type(2)));
        const int b = u.pm >> 3; const int colb = u.pn * BM + wc * 32 + 4 * fq;
#pragma unroll
        for (int bj = 0; bj < 2; ++bj)
#pragma unroll
            for (int n = 0; n < 2; ++n) { const int col = colb + bj * HALF + n * 16;
                const f32x4 g2 = *(const f32x4*)(modg + b * 6144 + col);
#pragma unroll
                for (int ai = 0; ai < 2; ++ai)
#pragma unroll
                    for (int m = 0; m < 4; ++m) { const int row = u.pm * BM + ai * HALF + wr * 64 + m * 16 + fr;
                        const u32x2 hw = *(const u32x2*)(H1 + (size_t)row * 1024 + col);
                        f32x4 h; h[0] = __uint_as_float(hw.x << 16); h[1] = __uint_as_float(hw.x & 0xffff0000u); h[2] = __uint_as_float(hw.y << 16); h[3] = __uint_as_float(hw.y & 0xffff0000u);
                        *(f32x4*)(O + (size_t)row * 1024 + col) = h * alpha + g2 * acc[ai][bj][m][n]; } }
    }
};
struct InProjOrder {
    StaticOrder so; int G, c;
    __host__ __device__ void init(int G_, int c_) { so.init(16384, 3072, G_, c_); G = G_; c = c_; }
    __host__ __device__ bool next(int i, Unit& u) const {
        const long L = (long)i * G + c; if (L < 768) return so.next(i, u);
        const int e = (int)(L - 768); if (e >= 24) return false; u.pm = 64 + e / 3; u.pn = 8 + e % 3; return true; }
    __device__ __forceinline__ void a_ready(const Unit&) const {}
    __device__ __forceinline__ void done(const Unit&) const {}
};
template <class Epi, class Sched, bool ALIGN_EPI = false, bool SP2 = false>
__device__ __forceinline__ void gemm_phase(PG8_LAS unsigned char* lds, const Gemm g, const Sched& S, const Epi& E) {
    const int tid = threadIdx.x, wid = __builtin_amdgcn_readfirstlane(tid >> 6), lane = tid & 63, wr = wid >> 2, wc = wid & 3, fr = lane & 15, fq = lane >> 4;
    const int K = g.K, nt = K / BK;
    unsigned voffA[2], voffB[2];
#pragma unroll
    for (int i = 0; i < 2; ++i) { int R, C; stage_rc(tid * 16 + i * 8192, R, C); const int Rb = Epi::PERM ? ((R & ~31) + perm32(R & 31)) : R;
        voffA[i] = (unsigned)(R * K + C) * 2u; voffB[i] = (unsigned)(Rb * K + C) * 2u; }
    const size_t kstep = (size_t)(BK * 2);
    const size_t hstep = (size_t)HALF * K * 2;
    const size_t tstep = 2 * hstep;
    const unsigned ldsw = (unsigned)wid * 1024u;
    const int aoff = lds_byte(wr * 64 + fr, fq * 8), boff = lds_byte(wc * 32 + fr, fq * 8);
#define PG8_SA(b, h) (((b) * 2 + (h)) * HTB)
#define PG8_SB(b, h) ((4 + (b) * 2 + (h)) * HTB)
#define PG8_STAGE(bufoff, gbase, voff) do { _Pragma("unroll") for (int _i = 0; _i < 2; ++_i) \
        __builtin_amdgcn_global_load_lds((const unsigned*)((const char*)(gbase) + (voff)[_i]), (PG8_LAS unsigned*)(lds + (bufoff) + ldsw + _i * 8192), 16, 0, 0); } while (0)
#define PG8_LDA(dst, b, h) do { _Pragma("unroll") for (int m = 0; m < 4; ++m) _Pragma("unroll") for (int k = 0; k < 2; ++k) dst[m][k] = *(const PG8_LAS bf16x8*)(lds + PG8_SA(b, h) + aoff + m * 2048 + k * 1024); } while (0)
#define PG8_LDB(dst, b, h) do { _Pragma("unroll") for (int n = 0; n < 2; ++n) _Pragma("unroll") for (int k = 0; k < 2; ++k) dst[n][k] = *(const PG8_LAS bf16x8*)(lds + PG8_SB(b, h) + boff + n * 2048 + k * 1024); } while (0)
#define PG8_MMA(ai, bj, At, Bt) do { __builtin_amdgcn_s_setprio(1); _Pragma("unroll") for (int m = 0; m < 4; ++m) _Pragma("unroll") for (int n = 0; n < 2; ++n) _Pragma("unroll") for (int k = 0; k < 2; ++k) \
        acc[ai][bj][m][n] = __builtin_amdgcn_mfma_f32_16x16x32_bf16(Bt[n][k], At[m][k], acc[ai][bj][m][n], 0, 0, 0); __builtin_amdgcn_s_setprio(0); } while (0)
#define PG8_WAIT_V(n) asm volatile("s_waitcnt vmcnt(" #n ")" ::: "memory")
#define PG8_WAIT_L(n) asm volatile("s_waitcnt lgkmcnt(" #n ")" ::: "memory")
#define PG8_BAR __builtin_amdgcn_s_barrier()
#define PG8_SCHED __builtin_amdgcn_sched_barrier(0)
    Unit cur, nxt; int ui = 0;
    if (!S.next(0, cur)) return;
    f32x4 acc[2][2][4][2];
#pragma unroll
    for (int a = 0; a < 2; ++a)
#pragma unroll
        for (int b = 0; b < 2; ++b)
#pragma unroll
            for (int m = 0; m < 4; ++m)
#pragma unroll
                for (int n = 0; n < 2; ++n) acc[a][b][m][n] = (f32x4){0.f, 0.f, 0.f, 0.f};
    bf16x8 At[4][2], B0[2][2], B1[2][2];
    const char* cA = (const char*)g.A + (size_t)cur.pm * tstep; const char* cB = (const char*)g.Bt + (size_t)cur.pn * tstep;
    S.a_ready(cur);
    if constexpr (SP2) {
        PG8_STAGE(PG8_SB(0, 0), cB, voffB); PG8_STAGE(PG8_SB(0, 1), cB + hstep, voffB); PG8_STAGE(PG8_SA(0, 0), cA, voffA); PG8_STAGE(PG8_SA(0, 1), cA + hstep, voffA);
        if (wr == 1) PG8_BAR;
        PG8_WAIT_V(2); PG8_BAR;
        PG8_STAGE(PG8_SB(1, 0), cB + kstep, voffB); PG8_STAGE(PG8_SA(1, 0), cA + kstep, voffA); PG8_STAGE(PG8_SB(1, 1), cB + hstep + kstep, voffB);
        PG8_WAIT_V(6); PG8_BAR;
    } else {
        PG8_STAGE(PG8_SB(0, 0), cB, voffB); PG8_STAGE(PG8_SA(0, 0), cA, voffA); PG8_STAGE(PG8_SB(0, 1), cB + hstep, voffB); PG8_STAGE(PG8_SA(0, 1), cA + hstep, voffA);
        if (wr == 1) PG8_BAR;
        PG8_WAIT_V(4); PG8_BAR;
        PG8_STAGE(PG8_SB(1, 0), cB + kstep, voffB); PG8_STAGE(PG8_SA(1, 0), cA + kstep, voffA); PG8_STAGE(PG8_SB(1, 1), cB + hstep + kstep, voffB);
        PG8_WAIT_V(6); PG8_BAR;
    }
    for (;;) {
        const bool has_next = S.next(ui + 1, nxt);
        const char* nA = has_next ? (const char*)g.A + (size_t)nxt.pm * tstep : cA; const char* nB = has_next ? (const char*)g.Bt + (size_t)nxt.pn * tstep : cB;
        for (int t = 0; t < nt; t += 2) {
            const bool last = (t == nt - 2);
            const char* a1 = cA + (size_t)(t + 1) * kstep;
            const char* a2 = last ? nA : cA + (size_t)(t + 2) * kstep; const char* b2 = last ? nB : cB + (size_t)(t + 2) * kstep;
            const char* a3 = a2 + kstep; const char* b3 = b2 + kstep;
            if (last && has_next) S.a_ready(nxt);
            if constexpr (SP2) {
            PG8_LDB(B0, 0, 0); PG8_LDB(B1, 0, 1); PG8_SCHED; PG8_LDA(At, 0, 0); PG8_STAGE(PG8_SA(1, 1), a1 + hstep, voffA);
            PG8_WAIT_V(8); PG8_WAIT_L(0); PG8_BAR; PG8_MMA(0, 0, At, B0); PG8_MMA(0, 1, At, B1); PG8_BAR; PG8_SCHED;
            PG8_LDA(At, 0, 1); PG8_STAGE(PG8_SB(0, 0), b2, voffB); PG8_STAGE(PG8_SB(0, 1), b2 + hstep, voffB); PG8_STAGE(PG8_SA(0, 0), a2, voffA);
            PG8_WAIT_V(8); PG8_WAIT_L(0); PG8_BAR; PG8_MMA(1, 0, At, B0); PG8_MMA(1, 1, At, B1); PG8_BAR; PG8_SCHED;
            PG8_LDB(B0, 1, 0); PG8_LDB(B1, 1, 1); PG8_SCHED; PG8_LDA(At, 1, 0); PG8_STAGE(PG8_SA(0, 1), a2 + hstep, voffA);
            PG8_WAIT_V(8); PG8_WAIT_L(0); PG8_BAR; PG8_MMA(0, 0, At, B0); PG8_MMA(0, 1, At, B1); PG8_BAR; PG8_SCHED;
            PG8_LDA(At, 1, 1); PG8_STAGE(PG8_SB(1, 0), b3, voffB); PG8_STAGE(PG8_SB(1, 1), b3 + hstep, voffB); PG8_STAGE(PG8_SA(1, 0), a3, voffA);
            PG8_WAIT_V(8); PG8_WAIT_L(0); PG8_BAR; PG8_MMA(1, 0, At, B0); PG8_MMA(1, 1, At, B1); PG8_BAR; PG8_SCHED;
            } else {
            PG8_LDB(B0, 0, 0); PG8_SCHED; PG8_LDA(At, 0, 0); PG8_STAGE(PG8_SA(1, 1), a1 + hstep, voffA);
            PG8_WAIT_L(8); PG8_BAR; PG8_WAIT_L(0); PG8_MMA(0, 0, At, B0); PG8_BAR; PG8_SCHED;
            PG8_LDB(B1, 0, 1); PG8_STAGE(PG8_SB(0, 0), b2, voffB);
            PG8_BAR; PG8_WAIT_L(0); PG8_MMA(0, 1, At, B1); PG8_BAR;
            PG8_LDA(At, 0, 1); PG8_STAGE(PG8_SA(0, 0), a2, voffA);
            PG8_BAR; PG8_WAIT_L(0); PG8_MMA(1, 0, At, B0); PG8_BAR; PG8_SCHED;
            PG8_STAGE(PG8_SB(0, 1), b2 + hstep, voffB);
            PG8_WAIT_V(6); PG8_BAR; PG8_MMA(1, 1, At, B1); PG8_BAR;
            PG8_LDB(B0, 1, 0); PG8_SCHED; PG8_LDA(At, 1, 0); PG8_STAGE(PG8_SA(0, 1), a2 + hstep, voffA);
            PG8_WAIT_L(8); PG8_BAR; PG8_WAIT_L(0); PG8_MMA(0, 0, At, B0); PG8_BAR; PG8_SCHED;
            PG8_LDB(B1, 1, 1); PG8_STAGE(PG8_SB(1, 0), b3, voffB);
            PG8_BAR; PG8_WAIT_L(0); PG8_MMA(0, 1, At, B1); PG8_BAR;
            PG8_LDA(At, 1, 1); PG8_STAGE(PG8_SA(1, 0), a3, voffA);
            PG8_BAR; PG8_WAIT_L(0); PG8_MMA(1, 0, At, B0); PG8_BAR; PG8_SCHED;
            PG8_STAGE(PG8_SB(1, 1), b3 + hstep, voffB);
            PG8_WAIT_V(6); PG8_BAR; PG8_MMA(1, 1, At, B1); PG8_BAR;
            }
        }
        if constexpr (ALIGN_EPI) { if (wr == 0) PG8_BAR; }
        if constexpr (!Epi::AFTER_DRAIN) { E(acc, cur, wr, wc, fr, fq); S.done(cur); }
        if (!has_next) break;
#pragma unroll
        for (int a = 0; a < 2; ++a)
#pragma unroll
            for (int b = 0; b < 2; ++b)
#pragma unroll
                for (int m = 0; m < 4; ++m)
#pragma unroll
                    for (int n = 0; n < 2; ++n) acc[a][b][m][n] = (f32x4){0.f, 0.f, 0.f, 0.f};
        cur = nxt; cA = nA; cB = nB; ++ui;
        if constexpr (ALIGN_EPI) { if (wr == 1) PG8_BAR; }
    }
    PG8_WAIT_V(0);
    if constexpr (!ALIGN_EPI) { if (wr == 0) PG8_BAR; }
    PG8_BAR;
    if constexpr (Epi::AFTER_DRAIN) { E.fused(acc, cur, wr, wc, fr, fq, lds, wid, lane); S.done(cur); }
#undef PG8_SA
#undef PG8_SB
#undef PG8_STAGE
#undef PG8_LDA
#undef PG8_LDB
#undef PG8_MMA
#undef PG8_WAIT_V
#undef PG8_WAIT_L
#undef PG8_BAR
#undef PG8_SCHED
}
}

__device__ __forceinline__ void phase_conv(const Args& a, int bid, int nb) {
    const int tid = threadIdx.x, lane = tid & 63, wave = tid >> 6;
    const int gw = bid * NWAVES + wave, NGW = nb * NWAVES;
    const bf16* PROJ = (const bf16*)(a.ws + WS_PROJ);
    const bf16* U = (const bf16*)(a.ws + WS_U);
    const bf16* WDT = (const bf16*)(a.ws + WS_WDT_T);
    bf16* XB = (bf16*)(a.ws + WS_XBC);
    bf16* MG = (bf16*)(a.ws + WS_MERGED);
    float* DT = (float*)(a.ws + WS_DT);
    const float* scw = a.in[I_SCW]; const float* scb = a.in[I_SCB]; const float* cw = a.in[I_CONVW];
    for (int row = gw; row < MALL; row += NGW) {
        const bool lat = row < MLAT;
        const int pos = lat ? (row & 63) : ((row - MLAT) & 255), len = lat ? 64 : 256;
        const bool hasL = pos > 0, hasR = pos < len - 1;
        const bf16* P = PROJ + (size_t)row * NPROJ;
#pragma unroll
        for (int half = 0; half < 2; ++half) {
            const int ch0 = lane * 16 + half * 8;
            if (!lat && ch0 >= 768) continue;
            const v4u zc = {0u, 0u, 0u, 0u};
            const v4u cu = *(const v4u*)(P + XBC_OFF + ch0);
            const v4u le = hasL ? *(const v4u*)(P - NPROJ + XBC_OFF + ch0) : zc;
            const v4u ri = hasR ? *(const v4u*)(P + NPROJ + XBC_OFF + ch0) : zc;
            float o[8];
#pragma unroll
            for (int i = 0; i < 8; ++i) {
                const unsigned wc = i < 2 ? cu.x : i < 4 ? cu.y : i < 6 ? cu.z : cu.w;
                const unsigned wl = i < 2 ? le.x : i < 4 ? le.y : i < 6 ? le.z : le.w;
                const unsigned wr = i < 2 ? ri.x : i < 4 ? ri.y : i < 6 ? ri.z : ri.w;
                const float c = (i & 1) ? bfhi(wc) : bflo(wc), l = (i & 1) ? bfhi(wl) : bflo(wl), r = (i & 1) ? bfhi(wr) : bflo(wr);
                const int ch = ch0 + i;
                const float v = scw[ch] * l + scw[XBC + ch] * c + scw[2 * XBC + ch] * r + scb[ch];
                o[i] = silu_f(v);
            }
            v4u w; w.x = pk2(o[0], o[1]); w.y = pk2(o[2], o[3]); w.z = pk2(o[4], o[5]); w.w = pk2(o[6], o[7]);
            *(v4u*)(XB + (size_t)row * XBC + ch0) = w;
        }
        if (lat) {
            const int ch0 = lane * 8;
            const v4u zc = {0u, 0u, 0u, 0u};
            const v4u gb = *(const v4u*)(P + ch0);
            const v4u gc0 = *(const v4u*)(P + CONVW + ch0), gh0 = *(const v4u*)(P + 2 * CONVW + ch0);
            const v4u gcl = hasL ? *(const v4u*)(P - NPROJ + CONVW + ch0) : zc, ghl = hasL ? *(const v4u*)(P - NPROJ + 2 * CONVW + ch0) : zc;
            const v4u gcr = hasR ? *(const v4u*)(P + NPROJ + CONVW + ch0) : zc, ghr = hasR ? *(const v4u*)(P + NPROJ + 2 * CONVW + ch0) : zc;
            float o[8];
#pragma unroll
            for (int i = 0; i < 8; ++i) {
#define SEL(v) ((i & 1) ? bfhi(i < 2 ? v.x : i < 4 ? v.y : i < 6 ? v.z : v.w) : bflo(i < 2 ? v.x : i < 4 ? v.y : i < 6 ? v.z : v.w))
                const int ch = ch0 + i;
                const float pl = SEL(gcl) * SEL(ghl), pc = SEL(gc0) * SEL(gh0), pr = SEL(gcr) * SEL(ghr);
                o[i] = SEL(gb) * (cw[ch] * pl + cw[CONVW + ch] * pc + cw[2 * CONVW + ch] * pr);
#undef SEL
            }
            v4u w; w.x = pk2(o[0], o[1]); w.y = pk2(o[2], o[3]); w.z = pk2(o[4], o[5]); w.w = pk2(o[6], o[7]);
            *(v4u*)(MG + (size_t)row * D + ch0) = w;
        }
        {
            const v4u u0 = *(const v4u*)(U + (size_t)row * D + lane * 16), u1 = *(const v4u*)(U + (size_t)row * D + lane * 16 + 8);
            float uf[16];
            uf[0] = bflo(u0.x); uf[1] = bfhi(u0.x); uf[2] = bflo(u0.y); uf[3] = bfhi(u0.y); uf[4] = bflo(u0.z); uf[5] = bfhi(u0.z); uf[6] = bflo(u0.w); uf[7] = bfhi(u0.w);
            uf[8] = bflo(u1.x); uf[9] = bfhi(u1.x); uf[10] = bflo(u1.y); uf[11] = bfhi(u1.y); uf[12] = bflo(u1.z); uf[13] = bfhi(u1.z); uf[14] = bflo(u1.w); uf[15] = bfhi(u1.w);
            float mine = 0.f;
#pragma unroll
            for (int j = 0; j < 16; ++j) {
                const v4u w0 = *(const v4u*)(WDT + j * 1024 + lane * 16), w1 = *(const v4u*)(WDT + j * 1024 + lane * 16 + 8);
                float p = uf[0] * bflo(w0.x) + uf[1] * bfhi(w0.x) + uf[2] * bflo(w0.y) + uf[3] * bfhi(w0.y) + uf[4] * bflo(w0.z) + uf[5] * bfhi(w0.z) + uf[6] * bflo(w0.w) + uf[7] * bfhi(w0.w)
                        + uf[8] * bflo(w1.x) + uf[9] * bfhi(w1.x) + uf[10] * bflo(w1.y) + uf[11] * bfhi(w1.y) + uf[12] * bflo(w1.z) + uf[13] * bfhi(w1.z) + uf[14] * bflo(w1.w) + uf[15] * bfhi(w1.w);
                p = wave_sum(p);
                if (lane == j) mine = p;
            }
            if (lane < 16) DT[(size_t)row * 16 + lane] = softplus_f(mine + a.in[I_DTB][lane]);
        }
    }
}

__device__ __forceinline__ void phase_ssd_naive(const Args& a, unsigned char* lds, int bid, int nb) {
    const int tid = threadIdx.x, p = tid >> 3, nq = tid & 7;
    float* sx = (float*)lds;
    float* sB = sx + 64 * 64;
    float* sC = sB + 64 * 128;
    float* sdt = sC + 64 * 128;
    const bf16* XB = (const bf16*)(a.ws + WS_XBC);
    const float* DT = (const float*)(a.ws + WS_DT);
    bf16* YD = (bf16*)(a.ws + WS_YDIR);
    for (int item = bid; item < NBATCH * 2 * NH; item += nb) {
        const int b = item & 7, dir = (item >> 3) & 1, h = item >> 4, g = h >> 2;
        const float ah = -__expf(a.in[I_ALOG][dir * 8 + h]);
        float S[16];
#pragma unroll
        for (int i = 0; i < 16; ++i) S[i] = 0.f;
        for (int blk = 0; blk < 36; ++blk) {
            const bool isctx = blk < 4;
            int bi = isctx ? blk : blk - 4; const int nblk = isctx ? 4 : 32; if (dir) bi = nblk - 1 - bi;
            const int rowbase = isctx ? MLAT + b * CTXL + bi * 64 : b * SEQ + bi * 64;
            __syncthreads();
            { const int idx = tid * 8, t = idx >> 6, p0 = idx & 63;
              const v4u w = *(const v4u*)(XB + (size_t)(rowbase + t) * XBC + h * 64 + p0); float* d = sx + t * 64 + p0;
              d[0] = bflo(w.x); d[1] = bfhi(w.x); d[2] = bflo(w.y); d[3] = bfhi(w.y); d[4] = bflo(w.z); d[5] = bfhi(w.z); d[6] = bflo(w.w); d[7] = bfhi(w.w); }
#pragma unroll
            for (int it = 0; it < 2; ++it) { const int idx = tid * 8 + it * 4096, t = idx >> 7, n0 = idx & 127;
              { const v4u w = *(const v4u*)(XB + (size_t)(rowbase + t) * XBC + 512 + g * 128 + n0); float* d = sB + t * 128 + n0;
                d[0] = bflo(w.x); d[1] = bfhi(w.x); d[2] = bflo(w.y); d[3] = bfhi(w.y); d[4] = bflo(w.z); d[5] = bfhi(w.z); d[6] = bflo(w.w); d[7] = bfhi(w.w); }
              if (!isctx) { const v4u w = *(const v4u*)(XB + (size_t)(rowbase + t) * XBC + 768 + g * 128 + n0); float* d = sC + t * 128 + n0;
                d[0] = bflo(w.x); d[1] = bfhi(w.x); d[2] = bflo(w.y); d[3] = bfhi(w.y); d[4] = bflo(w.z); d[5] = bfhi(w.z); d[6] = bflo(w.w); d[7] = bfhi(w.w); } }
            if (tid < 64) sdt[tid] = DT[(size_t)(rowbase + tid) * 16 + dir * 8 + h];
            __syncthreads();
            for (int tt = 0; tt < 64; ++tt) {
                const int t = dir ? 63 - tt : tt;
                const float dtv = sdt[t], dA = __expf(dtv * ah), xv = sx[t * 64 + p] * dtv;
                float y = 0.f;
#pragma unroll
                for (int i = 0; i < 16; ++i) { S[i] = dA * S[i] + xv * sB[t * 128 + nq * 16 + i]; if (!isctx) y += S[i] * sC[t * 128 + nq * 16 + i]; }
                if (!isctx) {
                    y += __shfl_xor(y, 1); y += __shfl_xor(y, 2); y += __shfl_xor(y, 4);
                    if (nq == 0) YD[(size_t)dir * MLAT * SSDW + (size_t)(rowbase + t) * SSDW + h * 64 + p] = (bf16)f2bf(y);
                }
            }
        }
    }
}


typedef short bf16x8 __attribute__((ext_vector_type(8)));
__device__ __forceinline__ void tr_read2(unsigned a0, unsigned a1, v2u& r0, v2u& r1) {
    asm volatile("ds_read_b64_tr_b16 %0, %2\n\tds_read_b64_tr_b16 %1, %3\n\ts_waitcnt lgkmcnt(0)" : "=&v"(r0), "=&v"(r1) : "v"(a0), "v"(a1) : "memory");
}
__device__ __forceinline__ unsigned cvtpk(float lo, float hi) { unsigned r; asm volatile("v_cvt_pk_bf16_f32 %0, %1, %2" : "=v"(r) : "v"(lo), "v"(hi)); return r; }
__device__ __forceinline__ bf16x8 mk_frag(unsigned a, unsigned b, unsigned c, unsigned d) { v4u f = {a, b, c, d}; return __builtin_bit_cast(bf16x8, f); }

__device__ __forceinline__ void phase_ssd(const Args& a, unsigned char* lds_g, int bid, int nb) {
    const int tid = threadIdx.x, lane = tid & 63, w = __builtin_amdgcn_readfirstlane(tid >> 6), i = lane & 15, g = lane >> 4, q = i >> 2, pp = i & 3;
    constexpr int BP = 272, XP = 80, XS_OFF = 34816, SS_OFF = 45056, SS_SZ = 8704, AR_OFF = 62464;
    LAS unsigned char* lds = (LAS unsigned char*)lds_g;
    LAS unsigned char* Bs = lds; LAS unsigned char* Xs = lds + XS_OFF; LAS unsigned char* Ss = lds + SS_OFF;
    LAS float* csA = (LAS float*)(lds + AR_OFF); LAS float* dtA = csA + 128; LAS float* wA = dtA + 128; LAS float* totA = wA + 128;
    const unsigned ldsb = (unsigned)(size_t)lds_g;
    const bf16* XB = (const bf16*)(a.ws + WS_XBC);
    const float* DT = (const float*)(a.ws + WS_DT);
    bf16* YD = (bf16*)(a.ws + WS_YDIR);
    for (int item = bid; item < 256; item += nb) {
        const int b = item & 7, rest = item >> 3, dir = rest & 1, h = (rest >> 1) & 7, ph = rest >> 4, grp = h >> 2;
        const float ah = -__expf(a.in[I_ALOG][dir * 8 + h]);
        f32x4 Sacc[2]; Sacc[0] = (f32x4){0.f, 0.f, 0.f, 0.f}; Sacc[1] = Sacc[0];
        __syncthreads();
        for (int k = tid; k < SS_SZ / 4; k += NT) ((LAS unsigned*)Ss)[k] = 0u;
        v4u pB[4], pX, pC[4]; float pdt0 = 0.f, pdt1 = 0.f;
#define SSD_ROWBASE(c) ((c) < 2 ? MLAT + b * CTXL + (dir ? 1 - (c) : (c)) * 128 : b * SEQ + (dir ? 15 - ((c) - 2) : ((c) - 2)) * 128)
#define SSD_PREFETCH(c) do { const int rb_ = SSD_ROWBASE(c); \
        _Pragma("unroll") for (int k = 0; k < 4; ++k) { const int piece = tid + 512 * k, row = piece >> 4, c16 = piece & 15; \
            pB[k] = *(const v4u*)(XB + (size_t)(rb_ + row) * XBC + 512 + grp * 128 + c16 * 8); } \
        { const int row = tid >> 2, cc = tid & 3; pX = *(const v4u*)(XB + (size_t)(rb_ + row) * XBC + h * 64 + ph * 32 + cc * 8); } \
        if ((c) >= 2) { _Pragma("unroll") for (int ks = 0; ks < 4; ++ks) pC[ks] = *(const v4u*)(XB + (size_t)(rb_ + 16 * w + i) * XBC + 768 + grp * 128 + 32 * ks + 8 * g); } \
        if (w == 0) { pdt0 = DT[(size_t)(rb_ + lane) * 16 + dir * 8 + h]; pdt1 = DT[(size_t)(rb_ + 64 + lane) * 16 + dir * 8 + h]; } } while (0)
        SSD_PREFETCH(0);
        for (int c = 0; c < 18; ++c) {
            const bool isctx = c < 2;
            const int rb = SSD_ROWBASE(c);
            __syncthreads();
#pragma unroll
            for (int k = 0; k < 4; ++k) { const int piece = tid + 512 * k, row = piece >> 4, c16 = piece & 15; *(LAS v4u*)(Bs + row * BP + c16 * 16) = pB[k]; }
            { const int row = tid >> 2, cc = tid & 3; *(LAS v4u*)(Xs + row * XP + cc * 16) = pX; }
            bf16x8 cfrag[4];
#pragma unroll
            for (int ks = 0; ks < 4; ++ks) cfrag[ks] = __builtin_bit_cast(bf16x8, pC[ks]);
            if (w == 0) {
                const float d0 = pdt0, d1 = pdt1, a0 = d0 * ah, a1 = d1 * ah;
                float s0 = a0, s1 = a1;
#pragma unroll
                for (int o = 1; o < 64; o <<= 1) { const float t0 = __shfl_up(s0, o), t1 = __shfl_up(s1, o); if (lane >= o) { s0 += t0; s1 += t1; } }
                const float sum0 = __shfl(s0, 63); s1 += sum0; const float tot = __shfl(s1, 63);
                const float c0 = dir ? tot - s0 + a0 : s0, c1 = dir ? tot - s1 + a1 : s1;
                csA[lane] = c0; csA[64 + lane] = c1; dtA[lane] = d0; dtA[64 + lane] = d1;
                wA[lane] = d0 * __expf(fminf(tot - c0, 0.f)); wA[64 + lane] = d1 * __expf(fminf(tot - c1, 0.f));
                if (lane == 0) totA[0] = tot;
            }
            __syncthreads();
            if (c + 1 < 18) SSD_PREFETCH(c + 1);
            const float csl = csA[16 * w + i], tot = totA[0];
            LAS unsigned char* Sr = Ss + (c & 1) * SS_SZ; LAS unsigned char* Sw = Ss + ((c + 1) & 1) * SS_SZ;
            if (!isctx) {
                f32x4 Y[2]; Y[0] = (f32x4){0.f, 0.f, 0.f, 0.f}; Y[1] = Y[0];
#pragma unroll
                for (int pt = 0; pt < 2; ++pt)
#pragma unroll
                    for (int ks = 0; ks < 4; ++ks) { const bf16x8 af = *(const LAS bf16x8*)(Sr + (16 * pt + i) * BP + (32 * ks + 8 * g) * 2);
                        Y[pt] = __builtin_amdgcn_mfma_f32_16x16x32_bf16(af, cfrag[ks], Y[pt], 0, 0, 0); }
                const float el = __expf(fminf(csl, 0.f));
                Y[0] = Y[0] * el; Y[1] = Y[1] * el;
                const int pj0 = dir ? (w >> 1) : 0, pj1 = dir ? 3 : (w >> 1);
                const int l = 16 * w + i;
                for (int pj = pj0; pj <= pj1; ++pj) {
                    unsigned mh[4];
#pragma unroll
                    for (int t = 0; t < 2; ++t) { const int sb = 2 * pj + t;
                        f32x4 G = (f32x4){0.f, 0.f, 0.f, 0.f};
#pragma unroll
                        for (int ks = 0; ks < 4; ++ks) { const bf16x8 bfr = *(const LAS bf16x8*)(Bs + (16 * sb + i) * BP + (32 * ks + 8 * g) * 2);
                            G = __builtin_amdgcn_mfma_f32_16x16x32_bf16(bfr, cfrag[ks], G, 0, 0, 0); }
                        const f32x4 cs4 = *(const LAS f32x4*)(csA + 16 * sb + 4 * g), dt4 = *(const LAS f32x4*)(dtA + 16 * sb + 4 * g);
                        float m[4];
#pragma unroll
                        for (int j = 0; j < 4; ++j) { const int s = 16 * sb + 4 * g + j; const bool valid = dir ? (s >= l) : (s <= l);
                            const float e = __expf(fminf(csl - cs4[j], 0.f)); m[j] = valid ? G[j] * e * dt4[j] : 0.f; }
                        mh[2 * t] = cvtpk(m[0], m[1]); mh[2 * t + 1] = cvtpk(m[2], m[3]); }
                    const bf16x8 bm = mk_frag(mh[0], mh[1], mh[2], mh[3]);
#pragma unroll
                    for (int pt = 0; pt < 2; ++pt) { const unsigned a0 = ldsb + XS_OFF + (32 * pj + 4 * g + q) * XP + (16 * pt + 4 * pp) * 2; v2u r0, r1; tr_read2(a0, a0 + 16 * XP, r0, r1);
                        Y[pt] = __builtin_amdgcn_mfma_f32_16x16x32_bf16(mk_frag(r0.x, r0.y, r1.x, r1.y), bm, Y[pt], 0, 0, 0); }
                }
#pragma unroll
                for (int pt = 0; pt < 2; ++pt) { v2u o; o.x = cvtpk(Y[pt][0], Y[pt][1]); o.y = cvtpk(Y[pt][2], Y[pt][3]);
                    *(v2u*)(YD + (size_t)dir * MLAT * SSDW + (size_t)(rb + l) * SSDW + h * 64 + ph * 32 + 16 * pt + 4 * g) = o; }
            }
            { const float dtot = __expf(fminf(tot, 0.f)); Sacc[0] = Sacc[0] * dtot; Sacc[1] = Sacc[1] * dtot; }
#pragma unroll
            for (int ks = 0; ks < 4; ++ks) {
                const unsigned ab0 = ldsb + (32 * ks + 8 * g + q) * BP + (16 * w + 4 * pp) * 2; v2u b0, b1; tr_read2(ab0, ab0 + 4 * BP, b0, b1);
                const bf16x8 bfr = mk_frag(b0.x, b0.y, b1.x, b1.y);
                const f32x4 w4a = *(const LAS f32x4*)(wA + 32 * ks + 8 * g), w4b = *(const LAS f32x4*)(wA + 32 * ks + 8 * g + 4);
#pragma unroll
                for (int pt = 0; pt < 2; ++pt) { const unsigned ax0 = ldsb + XS_OFF + (32 * ks + 8 * g + q) * XP + (16 * pt + 4 * pp) * 2; v2u r0, r1; tr_read2(ax0, ax0 + 4 * XP, r0, r1);
                    const unsigned f0 = cvtpk(bflo(r0.x) * w4a[0], bfhi(r0.x) * w4a[1]), f1 = cvtpk(bflo(r0.y) * w4a[2], bfhi(r0.y) * w4a[3]);
                    const unsigned f2 = cvtpk(bflo(r1.x) * w4b[0], bfhi(r1.x) * w4b[1]), f3 = cvtpk(bflo(r1.y) * w4b[2], bfhi(r1.y) * w4b[3]);
                    Sacc[pt] = __builtin_amdgcn_mfma_f32_16x16x32_bf16(mk_frag(f0, f1, f2, f3), bfr, Sacc[pt], 0, 0, 0); }
            }
#pragma unroll
            for (int pt = 0; pt < 2; ++pt)
#pragma unroll
                for (int j = 0; j < 4; ++j) *(LAS bf16*)(Sw + (16 * pt + 4 * g + j) * BP + (16 * w + i) * 2) = (bf16)f2bf(Sacc[pt][j]);
        }
#undef SSD_PREFETCH
#undef SSD_ROWBASE
    }
}
__device__ __forceinline__ void phase_fin(const Args& a, int bid, int nb) {
    const int tid = threadIdx.x, lane = tid & 63, wave = tid >> 6;
    const int gw = bid * NWAVES + wave, NGW = nb * NWAVES;
    const bf16* PROJ = (const bf16*)(a.ws + WS_PROJ);
    const bf16* XB = (const bf16*)(a.ws + WS_XBC);
    const bf16* YD = (const bf16*)(a.ws + WS_YDIR);
    bf16* MG = (bf16*)(a.ws + WS_MERGED);
    for (int row = gw; row < MLAT; row += NGW) {
        const int ch0 = lane * 8;
        const v4u yf = *(const v4u*)(YD + (size_t)row * SSDW + ch0), yb = *(const v4u*)(YD + (size_t)MLAT * SSDW + (size_t)row * SSDW + ch0);
        const v4u xs = *(const v4u*)(XB + (size_t)row * XBC + ch0), zz = *(const v4u*)(PROJ + (size_t)row * NPROJ + Z_OFF + ch0);
        const float dd = a.in[I_SSDD][ch0 >> 6];
        float o[8]; float ss = 0.f;
#pragma unroll
        for (int i = 0; i < 8; ++i) {
#define SEL(v) ((i & 1) ? bfhi(i < 2 ? v.x : i < 4 ? v.y : i < 6 ? v.z : v.w) : bflo(i < 2 ? v.x : i < 4 ? v.y : i < 6 ? v.z : v.w))
            const float y = SEL(yf) + SEL(yb) + SEL(xs) * dd;
            const float yg = y * silu_f(SEL(zz));
#undef SEL
            o[i] = yg; ss += yg * yg;
        }
        const float r = rsqrtf(wave_sum(ss) * (1.f / SSDW) + RMS_EPS);
        const float* nw = a.in[I_SNW] + ch0;
        v4u w; w.x = pk2(o[0] * r * nw[0], o[1] * r * nw[1]); w.y = pk2(o[2] * r * nw[2], o[3] * r * nw[3]);
        w.z = pk2(o[4] * r * nw[4], o[5] * r * nw[5]); w.w = pk2(o[6] * r * nw[6], o[7] * r * nw[7]);
        *(v4u*)(MG + (size_t)row * D + SSDW + ch0) = w;
    }
}

__device__ __forceinline__ void phase_ln1(const Args& a, int bid, int nb) {
    const int tid = threadIdx.x, lane = tid & 63, wave = tid >> 6;
    const int gw = bid * NWAVES + wave, NGW = nb * NWAVES;
    const float* MOD = (const float*)(a.ws + WS_MOD);
    const float* V = (const float*)(a.ws + WS_V1PRE);
    bf16* H1 = (bf16*)(a.ws + WS_H1); bf16* U2 = (bf16*)(a.ws + WS_U2);
    for (int row = gw; row < MLAT; row += NGW) {
        const int r = row / SEQ;
        const f32x4* xr = (const f32x4*)(V + (size_t)row * D) + lane;
        f32x4 v[4]; float s = 0.f;
#pragma unroll
        for (int j = 0; j < 4; ++j) { v[j] = xr[64 * j]; s += (v[j].x + v[j].y) + (v[j].z + v[j].w); }
        const float mean = wave_sum(s) * (1.f / D); float s2 = 0.f;
#pragma unroll
        for (int j = 0; j < 4; ++j) { v[j] = v[j] - mean; s2 += (v[j].x * v[j].x + v[j].y * v[j].y) + (v[j].z * v[j].z + v[j].w * v[j].w); }
        const float rstd = 1.f / sqrtf(wave_sum(s2) * (1.f / D) + LN_EPS);
        v2u* oh = (v2u*)(H1 + (size_t)row * D) + lane; v2u* ou = (v2u*)(U2 + (size_t)row * D) + lane;
#pragma unroll
        for (int j = 0; j < 4; ++j) {
            const int c = 4 * (lane + 64 * j);
            const f32x4 g = *(const f32x4*)(a.in[I_LN1G] + c), bb = *(const f32x4*)(a.in[I_LN1B] + c);
            const f32x4 sh = *(const f32x4*)(MOD + r * 6144 + 3072 + c), sc = *(const f32x4*)(MOD + r * 6144 + 4096 + c);
            const f32x4 h = v[j] * rstd * g + bb;
            const f32x4 u = h * (1.f + sc) + sh;
            v2u w; w.x = pk2(h.x, h.y); w.y = pk2(h.z, h.w); oh[64 * j] = w;
            v2u w2; w2.x = pk2(u.x, u.y); w2.y = pk2(u.z, u.w); ou[64 * j] = w2;
        }
    }
}
__device__ __forceinline__ void phase_ln2(const Args& a, int bid, int nb) {
    const int tid = threadIdx.x, lane = tid & 63, wave = tid >> 6;
    const int gw = bid * NWAVES + wave, NGW = nb * NWAVES;
    for (int row = gw; row < MLAT; row += NGW) {
        f32x4* xr = (f32x4*)(a.out + (size_t)row * D) + lane;
        f32x4 v[4]; float s = 0.f;
#pragma unroll
        for (int j = 0; j < 4; ++j) { v[j] = xr[64 * j]; s += (v[j].x + v[j].y) + (v[j].z + v[j].w); }
        const float mean = wave_sum(s) * (1.f / D); float s2 = 0.f;
#pragma unroll
        for (int j = 0; j < 4; ++j) { v[j] = v[j] - mean; s2 += (v[j].x * v[j].x + v[j].y * v[j].y) + (v[j].z * v[j].z + v[j].w * v[j].w); }
        const float rstd = 1.f / sqrtf(wave_sum(s2) * (1.f / D) + LN_EPS);
#pragma unroll
        for (int j = 0; j < 4; ++j) {
            const int c = 4 * (lane + 64 * j);
            const f32x4 g = *(const f32x4*)(a.in[I_LN2G] + c), bb = *(const f32x4*)(a.in[I_LN2B] + c);
            xr[64 * j] = v[j] * rstd * g + bb;
        }
    }
}


#define RLX_AGENT __ATOMIC_RELAXED, __HIP_MEMORY_SCOPE_AGENT
#define XB_TMO      128
#define XB_XCNT(j)  (256  + 64 * (j))
#define XB_XSUB(j)  (1280 + 64 * (j))
#define XB_XGEN(j)  (2304 + 64 * (j))
#define XB_TOP      3328
#define XB_TOPGEN   3392
#define XCD_BAR_WORDS 3456
#define XB_SPIN_CAP (1u << 18)

__device__ __forceinline__ unsigned xb_ld(unsigned* p)              { return __hip_atomic_load(p, __ATOMIC_RELAXED, __HIP_MEMORY_SCOPE_AGENT); }
__device__ __forceinline__ unsigned xb_add(unsigned* p, unsigned v) { return __hip_atomic_fetch_add(p, v, __ATOMIC_RELAXED, __HIP_MEMORY_SCOPE_AGENT); }
__device__ __forceinline__ unsigned xb_xcc_id() { return (unsigned)__builtin_amdgcn_s_getreg((3 << 11) | 20) & 0xFu; }
#define XB_SPIN(cond, bar) do { unsigned _sp = 0; while (cond) { __builtin_amdgcn_s_sleep(1); \
    if ((++_sp & 255u) == 0u) { if (xb_ld(&(bar)[XB_TMO])) break; if (_sp > XB_SPIN_CAP) { atomicAdd(&(bar)[XB_TMO], 1u); break; } } } } while (0)

struct XcdBarrier {
    unsigned* bar; unsigned x;
    volatile LAS unsigned* st;
};

__device__ __forceinline__ XcdBarrier xcd_barrier_post(unsigned* bar, volatile LAS unsigned* st) {
    XcdBarrier b; b.bar = bar; b.x = xb_xcc_id(); b.st = st;
    if (threadIdx.x == 0) (void)xb_add(&bar[XB_XCNT(b.x)], 1u);
    return b;
}
__device__ __forceinline__ void xcd_barrier_complete(unsigned* bar, unsigned x, unsigned& nloc, unsigned& nx) {
    const unsigned G = gridDim.x * gridDim.y * gridDim.z;
    unsigned sum, cnt, mine, sp = 0u;
    for (;;) {
        sum = 0u; cnt = 0u; mine = 0u;
#pragma unroll
        for (unsigned j = 0; j < 16; ++j) { const unsigned c = xb_ld(&bar[XB_XCNT(j)]); sum += c; cnt += (c > 0u) ? 1u : 0u; mine = (j == x) ? c : mine; }
        if (sum == G) break;
        __builtin_amdgcn_s_sleep(1);
        if ((++sp & 255u) == 0u) { if (xb_ld(&bar[XB_TMO])) break; if (sp > XB_SPIN_CAP) { atomicAdd(&bar[XB_TMO], 1u); break; } }
    }
    nloc = mine > 0u ? mine : 1u; nx = cnt > 0u ? cnt : 1u;
}

__device__ __forceinline__ void xcd_barrier(const XcdBarrier& b) {
    asm volatile("s_waitcnt vmcnt(0)" ::: "memory");
    __syncthreads();
    if (threadIdx.x == 0) {
        unsigned* bar = b.bar;
        __builtin_amdgcn_s_waitcnt(0);
        unsigned nloc = b.st[0], nx = b.st[1];
        if (nloc == 0u) { xcd_barrier_complete(bar, b.x, nloc, nx); b.st[0] = nloc; b.st[1] = nx; }
        const unsigned old = xb_add(&bar[XB_XSUB(b.x)], 1u);
        const unsigned gen = old / nloc;
        if (old + 1u == (gen + 1u) * nloc) {
            __builtin_amdgcn_fence(__ATOMIC_RELEASE, "agent");
            asm volatile("s_waitcnt vmcnt(0)" ::: "memory");
            const unsigned og = xb_add(&bar[XB_TOP], 1u);
            const unsigned tg = og / nx;
            if (og + 1u == (tg + 1u) * nx) xb_add(&bar[XB_TOPGEN], 1u);
            else XB_SPIN(xb_ld(&bar[XB_TOPGEN]) == tg, bar);
            __builtin_amdgcn_fence(__ATOMIC_ACQUIRE, "agent");
            xb_add(&bar[XB_XGEN(b.x)], 1u);
            asm volatile("s_waitcnt vmcnt(0)" ::: "memory");
        } else {
            XB_SPIN(xb_ld(&bar[XB_XGEN(b.x)]) == gen, bar);
            __builtin_amdgcn_fence(__ATOMIC_ACQUIRE, "agent");
            asm volatile("s_waitcnt vmcnt(0)" ::: "memory");
        }
    }
    __syncthreads();
}
__global__ void __launch_bounds__(NT, 2) mk_fwd(Args a) {
    extern __shared__ __attribute__((aligned(16))) unsigned char lds[];
    const int bid = blockIdx.x, nb = gridDim.x;
    const int lo = a.ph_lo, hi = a.ph_hi;
    unsigned char* ws = a.ws;
#define IN(k) (lo <= (k) && (k) < hi)
#define REPEAT(k) for (int r_ = 0; r_ < REP[k]; ++r_)
#define SEAM(k) do { if (IN(k) && IN((k) + 1)) { xcd_barrier(bar); } } while (0)
    if (a.ph_hi > 1000) cg::this_grid().sync();
    volatile LAS unsigned* misc = (volatile LAS unsigned*)((LAS unsigned char*)lds + LDS_MISC);
    if (threadIdx.x < 2) misc[threadIdx.x] = 0u;
    __syncthreads();
    XcdBarrier bar = xcd_barrier_post((unsigned*)(ws + WS_BAR), misc);
    if (IN(0)) REPEAT(0) phase_p0a(a, lds, bid, nb);
    SEAM(0);
    if (IN(1)) REPEAT(1) phase_p0b(a, bid, nb);
    SEAM(1);
    if (IN(2)) REPEAT(2) {
        pg8::Gemm g{(const bf16*)(ws + WS_U), (const bf16*)(ws + WS_WIN_T), MALL, NPROJ, D}; pg8::InProjOrder S; S.init(nb, bid);
        pg8::EpiBf16<0> E{(bf16*)(ws + WS_PROJ), NPROJ};
        pg8::gemm_phase<pg8::EpiBf16<0>, pg8::InProjOrder, true, true>((LAS unsigned char*)lds, g, S, E);
    }
    SEAM(2);
    if (IN(3)) REPEAT(3) phase_conv(a, bid, nb);
    SEAM(3);
    if (IN(4)) REPEAT(4) phase_ssd(a, lds, bid, nb);
    SEAM(4);
    if (IN(5)) REPEAT(5) phase_fin(a, bid, nb);
    SEAM(5);
    if (IN(6)) REPEAT(6) {
        pg8::Gemm g{(const bf16*)(ws + WS_MERGED), (const bf16*)(ws + WS_WOUT_T), MLAT, D, D}; pg8::StaticOrder S; S.init(MLAT, D, nb, bid);
        pg8::EpiRes1 E{a.in[I_X], (const float*)(ws + WS_STATS), a.in[I_LNG], a.in[I_LNB], (const float*)(ws + WS_MOD) + 2048, (float*)(ws + WS_V1PRE), ALPHA};
        pg8::gemm_phase<pg8::EpiRes1, pg8::StaticOrder, true, true>((LAS unsigned char*)lds, g, S, E);
    }
    SEAM(6);
    if (IN(7)) REPEAT(7) phase_ln1(a, bid, nb);
    SEAM(7);
    if (IN(8)) REPEAT(8) {
        pg8::Gemm g{(const bf16*)(ws + WS_U2), (const bf16*)(ws + WS_WFF1_T), MLAT, FF, D}; pg8::StaticOrder S; S.init(MLAT, FF, nb, bid);
        pg8::EpiBf16<1> E{(bf16*)(ws + WS_ACT), FF};
        pg8::gemm_phase<pg8::EpiBf16<1>, pg8::StaticOrder, true, true>((LAS unsigned char*)lds, g, S, E);
    }
    SEAM(8);
    if (IN(9)) REPEAT(9) {
        pg8::Gemm g{(const bf16*)(ws + WS_ACT), (const bf16*)(ws + WS_WFF2_T), MLAT, D, FF}; pg8::StaticOrder S; S.init(MLAT, D, nb, bid);
        pg8::EpiRes2 E{(const bf16*)(ws + WS_H1), (const float*)(ws + WS_MOD) + 5120, a.out, ALPHA};
        pg8::gemm_phase<pg8::EpiRes2, pg8::StaticOrder, true, true>((LAS unsigned char*)lds, g, S, E);
    }
    SEAM(9);
    if (IN(10)) phase_ln2(a, bid, nb);
#undef IN
#undef SEAM
}

extern "C" void kernel_launch(void* const* d_in, const int* in_sizes, int n_in, void* d_out, int out_size, void* d_ws, size_t ws_size, hipStream_t stream) {
    static int grid = 0;
    if (grid == 0) {
        if (n_in != 23 || out_size != MLAT * D || ws_size < WS_END) { fprintf(stderr, "kernel_launch: unexpected shapes n_in %d out %d ws %zu\n", n_in, out_size, ws_size); grid = -1; return; }
        int dev = 0, cus = 0, per_cu = 0;
        (void)hipGetDevice(&dev);
        (void)hipDeviceGetAttribute(&cus, hipDeviceAttributeMultiprocessorCount, dev);
        (void)hipFuncSetAttribute((const void*)mk_fwd, hipFuncAttributeMaxDynamicSharedMemorySize, LDS_BYTES);
        (void)hipOccupancyMaxActiveBlocksPerMultiprocessor(&per_cu, (const void*)mk_fwd, NT, LDS_BYTES);
        (void)hipGetLastError();
        if (per_cu < 1) { fprintf(stderr, "kernel_launch: occupancy query says %d blocks/CU\n", per_cu); per_cu = 1; }
        grid = cus;
    }
    if (grid < 0) return;
    Args a{};
    for (int i = 0; i < 23; ++i) a.in[i] = (const float*)d_in[i];
    a.out = (float*)d_out; a.ws = (unsigned char*)d_ws;
#if ONE_LAUNCH
    (void)hipMemsetAsync((char*)d_ws, 0, WS_BAR + BAR_BYTES, stream);
    a.ph_lo = 0; a.ph_hi = NPHASES;
    void* args[] = {&a};
    hipError_t e = hipLaunchCooperativeKernel((const void*)mk_fwd, dim3(grid), dim3(NT), args, LDS_BYTES, stream);
    if (e != hipSuccess) fprintf(stderr, "cooperative launch failed: %s (grid %d)\n", hipGetErrorString(e), grid);
#else
    for (int ph = 0; ph < NPHASES; ++ph) {
        a.ph_lo = ph; a.ph_hi = ph + 1;
        hipLaunchKernelGGL(mk_fwd, dim3(grid), dim3(NT), LDS_BYTES, stream, a);
    }
#endif
}
```
